# Optimizing an MI355X kernel written in HIP

```python
import math
import jax, jax.numpy as jnp
from jax import lax
import numpy as np

D_MODEL = 2048
BATCH = 2
SEQ = 4096
DEPTH = 4

CHUNK = 64
LEFT_CHUNKS = 8
BAND = (LEFT_CHUNKS + 1) * CHUNK
HEAD_DIM = 128
A_HEADS = 8
B_HEADS = 8
B_QK_DIM = HEAD_DIM // 2
A_WIDTH = A_HEADS * HEAD_DIM
B_WIDTH = B_HEADS * HEAD_DIM
MIX_WIDTH = A_WIDTH + B_WIDTH
IN_WIDTH = 3 * A_WIDTH + 3 * B_WIDTH
REL_CLIP = 128
T5_BUCKETS = 32
T5_MAX_DIST = 512
Q_BLOCK = 128
MEM_LEN = 256
X_HEADS = 4
X_HEAD_DIM = D_MODEL // X_HEADS
N_GROUPS = 4
EXPERTS_PER_GROUP = 8
N_EXPERTS = N_GROUPS * EXPERTS_PER_GROUP
TOP_K_INNER = 2
D_EXPERT = D_MODEL // 8

EPS = 1e-6
NEG_INF = -1e30

kernel_name = "hybrid_chunk_stream_diff_moe"


def rmsnorm(x, g):
    x32 = x.astype(jnp.float32)
    y = x32 * lax.rsqrt(jnp.mean(x32 * x32, axis=-1, keepdims=True) + EPS)
    return (y * g.astype(jnp.float32)).astype(x.dtype)


def t5_bucket(rel):
    half = T5_BUCKETS // 2
    max_exact = half // 2
    ret = jnp.where(rel > 0, half, 0)
    n = jnp.abs(rel)
    n_f = jnp.maximum(n, max_exact).astype(jnp.float32)
    large = max_exact + (jnp.log(n_f / max_exact) / math.log(T5_MAX_DIST / max_exact)
                         * (half - max_exact)).astype(jnp.int32)
    large = jnp.minimum(large, half - 1)
    return ret + jnp.where(n < max_exact, n, large)


def chunked_band_attention(q, k, v, rel_table):
    b, s, h, dh = q.shape
    nc = s // CHUNK
    qc = q.reshape(b, nc, CHUNK, h, dh)
    pad = ((0, 0), (LEFT_CHUNKS * CHUNK, 0), (0, 0), (0, 0))
    kp = jnp.pad(k, pad).reshape(b, nc + LEFT_CHUNKS, CHUNK, h, dh)
    vp = jnp.pad(v, pad).reshape(b, nc + LEFT_CHUNKS, CHUNK, h, dh)
    band_idx = jnp.arange(nc)[:, None] + jnp.arange(LEFT_CHUNKS + 1)[None, :]
    kb = kp[:, band_idx].reshape(b, nc, BAND, h, dh)
    vb = vp[:, band_idx].reshape(b, nc, BAND, h, dh)
    logits = jnp.einsum('bcqhd,bckhd->bhcqk', qc, kb).astype(jnp.float32) * (dh ** -0.5)
    rel = (jnp.arange(BAND)[None, :] - LEFT_CHUNKS * CHUNK) - jnp.arange(CHUNK)[:, None]
    bias = rel_table[jnp.clip(rel, -REL_CLIP, REL_CLIP) + REL_CLIP].astype(jnp.float32)
    logits = logits + bias.transpose(2, 0, 1)[None, :, None]
    valid = jnp.repeat(band_idx >= LEFT_CHUNKS, CHUNK, axis=1)
    logits = jnp.where(valid[None, None, :, None, :], logits, NEG_INF)
    p = jax.nn.softmax(logits, axis=-1).astype(v.dtype)
    o = jnp.einsum('bhcqk,bckhd->bcqhd', p, vb)
    return o.reshape(b, s, h * dh)


def diff_attention(q, k, v, t5_table, lam_vecs, subln_g, lam_init):
    b, s, h, _, dq = q.shape
    dh = v.shape[-1]
    nblk = s // Q_BLOCK
    lv = lam_vecs.astype(jnp.float32)
    lam = jnp.exp(jnp.sum(lv[0] * lv[1])) - jnp.exp(jnp.sum(lv[2] * lv[3])) + lam_init
    kpos = jnp.arange(s)
    kchunk = kpos // CHUNK
    scale = dq ** -0.5
    qblocks = q.reshape(b, nblk, Q_BLOCK, h, 2, dq).transpose(1, 0, 2, 3, 4, 5)

    def block(args):
        qblk, i = args
        qpos = i * Q_BLOCK + jnp.arange(Q_BLOCK)
        logits = jnp.einsum('bqhmd,bkhmd->bmhqk', qblk, k).astype(jnp.float32) * scale
        bias = t5_table[t5_bucket(kpos[None, :] - qpos[:, None])].astype(jnp.float32)
        logits = logits + bias.transpose(2, 0, 1)[None, None]
        mask = kchunk[None, :] <= (qpos // CHUNK)[:, None]
        logits = jnp.where(mask, logits, NEG_INF)
        p = jax.nn.softmax(logits, axis=-1)
        pd = p[:, 0] - lam * p[:, 1]
        return jnp.einsum('bhqk,bkhd->bqhd', pd.astype(v.dtype), v)

    o = lax.map(block, (qblocks, jnp.arange(nblk)))
    o = o.transpose(1, 0, 2, 3, 4).reshape(b, s, h, dh)
    o = rmsnorm(o, subln_g) * (1.0 - lam_init)
    return o.reshape(b, s, h * dh)


def cross_attention(xn, memn, wq, wkv, wo):
    b, s, d = xn.shape
    m = memn.shape[1]
    q = (xn @ wq).reshape(b, s, X_HEADS, X_HEAD_DIM)
    kv = (memn @ wkv).reshape(b, m, 2, X_HEADS, X_HEAD_DIM)
    logits = jnp.einsum('bshd,bmhd->bhsm', q, kv[:, :, 0]).astype(jnp.float32) * (X_HEAD_DIM ** -0.5)
    p = jax.nn.softmax(logits, axis=-1).astype(xn.dtype)
    o = jnp.einsum('bhsm,bmhd->bshd', p, kv[:, :, 1]).reshape(b, s, d)
    return o @ wo


def hier_moe(xn, w_group, b_group, w_expert, b_expert, w1, w3, w2):
    b, s, d = xn.shape
    t = xn.reshape(-1, d)
    n_tok = t.shape[0]
    g_logits = (t @ w_group).astype(jnp.float32) + b_group.astype(jnp.float32)
    g_prob = jax.nn.softmax(g_logits, axis=-1)
    g_gate, g_sel = lax.top_k(g_prob, 1)
    e_logits = ((t @ w_expert).astype(jnp.float32) + b_expert.astype(jnp.float32))
    e_logits = e_logits.reshape(n_tok, N_GROUPS, EXPERTS_PER_GROUP)
    e_in = jnp.take_along_axis(e_logits, g_sel[:, :, None], axis=1)[:, 0]
    top_val, top_idx = lax.top_k(e_in, TOP_K_INNER)
    top_w = jax.nn.softmax(top_val, axis=-1) * g_gate
    expert_id = g_sel * EXPERTS_PER_GROUP + top_idx
    combine = jnp.sum(jax.nn.one_hot(expert_id, N_EXPERTS, dtype=jnp.float32) * top_w[..., None], axis=1)
    hid = jax.nn.silu(jnp.einsum('td,edf->tef', t, w1)) * jnp.einsum('td,edf->tef', t, w3)
    hid = hid * combine[:, :, None].astype(hid.dtype)
    out = jnp.einsum('tef,efd->td', hid, w2)
    return out.reshape(b, s, d)


def setup_inputs(seed: int = 0) -> dict:
    key = jax.random.key(seed)
    ks = jax.random.split(key, 24)
    f32 = jnp.float32
    nrm = lambda k, shape, sc: jax.random.normal(k, shape, f32) * sc
    gain = lambda k, shape: 1.0 + 0.05 * jax.random.normal(k, shape, f32)
    return {
        "x": nrm(ks[0], (BATCH, SEQ, D_MODEL), 1.0),
        "mem": nrm(ks[1], (BATCH, MEM_LEN, D_MODEL), 1.0),
        "norm_mix": gain(ks[2], (DEPTH, D_MODEL)),
        "w_in": nrm(ks[3], (DEPTH, D_MODEL, IN_WIDTH), D_MODEL ** -0.5),
        "rel_bias_a": nrm(ks[4], (DEPTH, 2 * REL_CLIP + 1, A_HEADS), 0.5),
        "t5_table": nrm(ks[5], (T5_BUCKETS, B_HEADS), 0.5),
        "diff_lambda": nrm(ks[6], (DEPTH, 4, B_QK_DIM), 0.1),
        "diff_subln": gain(ks[7], (DEPTH, HEAD_DIM)),
        "w_out": nrm(ks[8], (DEPTH, MIX_WIDTH, D_MODEL), MIX_WIDTH ** -0.5),
        "norm_cross": gain(ks[9], (DEPTH, D_MODEL)),
        "norm_mem": gain(ks[10], (DEPTH, D_MODEL)),
        "w_xq": nrm(ks[11], (DEPTH, D_MODEL, D_MODEL), D_MODEL ** -0.5),
        "w_xkv": nrm(ks[12], (DEPTH, D_MODEL, 2 * D_MODEL), D_MODEL ** -0.5),
        "w_xo": nrm(ks[13], (DEPTH, D_MODEL, D_MODEL), D_MODEL ** -0.5),
        "norm_ffn": gain(ks[14], (DEPTH, D_MODEL)),
        "w_group": nrm(ks[15], (DEPTH, D_MODEL, N_GROUPS), D_MODEL ** -0.5),
        "b_group": nrm(ks[16], (DEPTH, N_GROUPS), 0.01),
        "w_expert": nrm(ks[17], (DEPTH, D_MODEL, N_EXPERTS), D_MODEL ** -0.5),
        "b_expert": nrm(ks[18], (DEPTH, N_EXPERTS), 0.01),
        "w1": nrm(ks[19], (DEPTH, N_EXPERTS, D_MODEL, D_EXPERT), D_MODEL ** -0.5),
        "w3": nrm(ks[20], (DEPTH, N_EXPERTS, D_MODEL, D_EXPERT), D_MODEL ** -0.5),
        "w2": nrm(ks[21], (DEPTH, N_EXPERTS, D_EXPERT, D_MODEL), D_EXPERT ** -0.5),
        "norm_final": gain(ks[22], (D_MODEL,)),
    }


def reference(x, mem, norm_mix, w_in, rel_bias_a, t5_table, diff_lambda, diff_subln, w_out,
              norm_cross, norm_mem, w_xq, w_xkv, w_xo, norm_ffn, w_group, b_group,
              w_expert, b_expert, w1, w3, w2, norm_final):
    b, s, _ = x.shape
    for l in range(DEPTH):
        lam_init = 0.8 - 0.6 * math.exp(-0.3 * l)
        h = rmsnorm(x, norm_mix[l])
        proj = h @ w_in[l]
        qa, ka, va, qb, kb, vb = jnp.split(proj, 6, axis=-1)
        oa = chunked_band_attention(qa.reshape(b, s, A_HEADS, HEAD_DIM),
                                    ka.reshape(b, s, A_HEADS, HEAD_DIM),
                                    va.reshape(b, s, A_HEADS, HEAD_DIM),
                                    rel_bias_a[l])
        ob = diff_attention(qb.reshape(b, s, B_HEADS, 2, B_QK_DIM),
                            kb.reshape(b, s, B_HEADS, 2, B_QK_DIM),
                            vb.reshape(b, s, B_HEADS, HEAD_DIM),
                            t5_table, diff_lambda[l], diff_subln[l], lam_init)
        x = x + jnp.concatenate([oa, ob], axis=-1) @ w_out[l]
        x = x + cross_attention(rmsnorm(x, norm_cross[l]), rmsnorm(mem, norm_mem[l]),
                                w_xq[l], w_xkv[l], w_xo[l])
        x = x + hier_moe(rmsnorm(x, norm_ffn[l]), w_group[l], b_group[l], w_expert[l],
                         b_expert[l], w1[l], w3[l], w2[l])
    return rmsnorm(x, norm_final)
```

```cpp
#include <hip/hip_runtime.h>
#include <cstdio>
#include <cstdint>

#ifndef MK_MULTI
#define MK_MULTI 0
#endif

typedef unsigned short bf16_t;
typedef short bf16x8 __attribute__((ext_vector_type(8)));
typedef int i32x4 __attribute__((ext_vector_type(4)));
typedef int i32x8 __attribute__((ext_vector_type(8)));
typedef float f32x16 __attribute__((ext_vector_type(16)));
typedef float f32x4 __attribute__((ext_vector_type(4)));
typedef unsigned u32x4 __attribute__((ext_vector_type(4)));
typedef unsigned u32x2 __attribute__((ext_vector_type(2)));
#define LAS __attribute__((address_space(3)))
#define GAS __attribute__((address_space(1)))
#define DI __device__ __forceinline__

constexpr int T = 8192, D = 2048, SEQ = 4096, NB = 2, NL = 4, INW = 6144;
constexpr int MEM = 256, MT = NB * MEM, NE = 32, DE = 256;
constexpr float EPS = 1e-6f;
constexpr float LOG2E = 1.4426950408889634f;
constexpr float SC_A = 0.08838834764831845f * LOG2E;
constexpr float SC_B = 0.125f * LOG2E;
constexpr float SC_X = 0.04419417382415922f * LOG2E;
constexpr int TABB_N = 640, TABB_OFF = 511;
constexpr int TABA_N = 320, TABA_OFF = 256;

constexpr size_t MiB = 1u << 20;
constexpr size_t WS_CTL = 0, CTL_BYTES = 1 * MiB;
constexpr int CW_BAR = 4096;
constexpr int CW_CNT = 16384, CNT_STRIDE = 16;
constexpr int CW_QH = 8192;
constexpr int CW_DONE = 8448;
constexpr size_t WS_TABB = 1 * MiB, WS_TABA = WS_TABB + 32768, WS_LAM = WS_TABB + 131072, WS_RMEM = WS_TABB + 135168;
static_assert(8 * TABB_N * 4 <= 32768 && NL * 8 * TABA_N * 4 <= 131072 - 32768, "bias tables fit their slots");
constexpr size_t WS_PART = 2 * MiB;
constexpr size_t WS_WRT = 3 * MiB;
constexpr size_t WS_LTOK = 5 * MiB, WS_LW = 6 * MiB, WS_LR = 7 * MiB;
constexpr size_t WS_XB = 16 * MiB, WS_MEMB = 48 * MiB, WS_KVB = 50 * MiB, WS_WQK = 66 * MiB, WS_VOT = 98 * MiB;
constexpr size_t WS_PROJ = 130 * MiB, WS_MIX = 226 * MiB, WS_P = 258 * MiB, WS_HID = 274 * MiB, WS_Y = 286 * MiB, WS_SCR = 350 * MiB;
constexpr size_t WS_WIN = 544 * MiB, WS_WOUT = 640 * MiB, WS_WQS = 672 * MiB, WS_WKV = 704 * MiB, WS_WXO = 768 * MiB, WS_W13 = 800 * MiB, WS_W2 = 1056 * MiB;
constexpr size_t WS_X8 = 1184 * MiB, WS_END = 1200 * MiB;
#ifndef F8_FROM
#define F8_FROM 1
#endif
#ifndef F8M_FROM
#define F8M_FROM 0
#endif
constexpr int L8M = F8M_FROM;
constexpr int L8 = F8_FROM;
constexpr float H8S = 16.f;
constexpr float Y8S = 16.f;
#ifndef F8B_FROM
#define F8B_FROM 2
#endif
constexpr int L8B = F8B_FROM;
#ifndef F8X_FROM
#define F8X_FROM 0
#endif
constexpr int L8X = F8X_FROM; static_assert(F8X_FROM == 0, "the prologue builds only the e4m3 Wqk / VoT");
constexpr float Q8S = 512.f;
constexpr float P8S = 256.f, V8S = 16.f;
constexpr int HID_ROWS = 24576;

constexpr int NWAVES = 8, NTHREADS = 512;
constexpr int LDS_BYTES = 147456;
constexpr int LDS_MISC = 139264;

DI float bf2f(bf16_t v) { return __uint_as_float((unsigned)v << 16); }
DI unsigned f2bf(float f) { unsigned u = __float_as_uint(f); return (u + 0x7fffu + ((u >> 16) & 1u)) >> 16; }
DI unsigned pk2(float lo, float hi) { return f2bf(lo) | (f2bf(hi) << 16); }
DI float bpx(float v, int lane, int m) { return __int_as_float(__builtin_amdgcn_ds_bpermute((lane ^ m) << 2, __float_as_int(v))); }
DI float sum_x16(float v, int lane) { return v + bpx(v, lane, 16); }
DI float max_x16(float v, int lane) { return fmaxf(v, bpx(v, lane, 16)); }
DI float sum_x32(float v, int lane) { return v + bpx(v, lane, 32); }
DI float max_x32(float v, int lane) { return fmaxf(v, bpx(v, lane, 32)); }
DI float wave_sum(float v, int lane) {
#pragma unroll
    for (int o = 1; o < 64; o <<= 1) v += bpx(v, lane, o);
    return v; }
DI float wave_max(float v, int lane) {
#pragma unroll
    for (int o = 1; o < 64; o <<= 1) v = fmaxf(v, bpx(v, lane, o));
    return v; }
DI float lane_get(float v, int src) { return __int_as_float(__builtin_amdgcn_ds_bpermute(src << 2, __float_as_int(v))); }
DI int crow(int r, int hi) { return (r & 3) + 8 * (r >> 2) + 4 * hi; }
#define MFMA32(a, b, c) __builtin_amdgcn_mfma_f32_32x32x16_bf16((a), (b), (c), 0, 0, 0)
#define LDS_WAIT() asm volatile("s_waitcnt lgkmcnt(0)" ::: "memory")
#define AT_BAR() asm volatile("s_waitcnt vmcnt(0) lgkmcnt(0)\n\ts_barrier" ::: "memory")

#define XB_TMO      128
#define XB_XCNT(j)  (256  + 64 * (j))
#define XB_XSUB(j)  (1280 + 64 * (j))
#define XB_XGEN(j)  (2304 + 64 * (j))
#define XB_TOP      3328
#define XB_TOPGEN   3392
#define XCD_BAR_WORDS 3456
#define XB_SPIN_CAP (1u << 18)
__device__ __forceinline__ unsigned xb_ld(unsigned* p)              { return __hip_atomic_load(p, __ATOMIC_RELAXED, __HIP_MEMORY_SCOPE_AGENT); }
__device__ __forceinline__ unsigned xb_add(unsigned* p, unsigned v) { return __hip_atomic_fetch_add(p, v, __ATOMIC_RELAXED, __HIP_MEMORY_SCOPE_AGENT); }
__device__ __forceinline__ unsigned xb_xcc_id() { return (unsigned)__builtin_amdgcn_s_getreg((3 << 11) | 20) & 0xFu; }
#define XB_SPIN(cond, bar) do { unsigned _sp = 0; while (cond) { __builtin_amdgcn_s_sleep(1); \
    if ((++_sp & 255u) == 0u) { if (xb_ld(&(bar)[XB_TMO])) break; if (_sp > XB_SPIN_CAP) { atomicAdd(&(bar)[XB_TMO], 1u); break; } } } } while (0)
struct XcdBarrier { unsigned* bar; unsigned x; volatile LAS unsigned* st; };
__device__ __forceinline__ XcdBarrier xcd_barrier_post(unsigned* bar, volatile LAS unsigned* st) {
    XcdBarrier b; b.bar = bar; b.x = xb_xcc_id(); b.st = st;
    if (threadIdx.x == 0) (void)xb_add(&bar[XB_XCNT(b.x)], 1u);
    return b;
}
__device__ __forceinline__ void xcd_barrier_complete(unsigned* bar, unsigned x, unsigned& nloc, unsigned& nx) {
    const unsigned G = gridDim.x * gridDim.y * gridDim.z;
    unsigned sum, cnt, mine, sp = 0u;
    for (;;) {
        sum = 0u; cnt = 0u; mine = 0u;
#pragma unroll
        for (unsigned j = 0; j < 16; ++j) { const unsigned c = xb_ld(&bar[XB_XCNT(j)]); sum += c; cnt += (c > 0u) ? 1u : 0u; mine = (j == x) ? c : mine; }
        if (sum == G) break;
        __builtin_amdgcn_s_sleep(1);
        if ((++sp & 255u) == 0u) { if (xb_ld(&bar[XB_TMO])) break; if (sp > XB_SPIN_CAP) { atomicAdd(&bar[XB_TMO], 1u); break; } }
    }
    nloc = mine > 0u ? mine : 1u; nx = cnt > 0u ? cnt : 1u;
}
__device__ __forceinline__ void xcd_barrier(const XcdBarrier& b, const int tid) {
    asm volatile("s_waitcnt vmcnt(0)" ::: "memory");
    __syncthreads();
    if (tid == 0) {
        unsigned* bar = b.bar;
        __builtin_amdgcn_s_waitcnt(0);
        unsigned nloc = b.st[0], nx = b.st[1];
        if (nloc == 0u) { xcd_barrier_complete(bar, b.x, nloc, nx); b.st[0] = nloc; b.st[1] = nx; }
        const unsigned old = xb_add(&bar[XB_XSUB(b.x)], 1u);
        const unsigned gen = old / nloc;
        if (old + 1u == (gen + 1u) * nloc) {
            __builtin_amdgcn_fence(__ATOMIC_RELEASE, "agent");
            asm volatile("s_waitcnt vmcnt(0)" ::: "memory");
            const unsigned og = xb_add(&bar[XB_TOP], 1u);
            const unsigned tg = og / nx;
            if (og + 1u == (tg + 1u) * nx) xb_add(&bar[XB_TOPGEN], 1u);
            else XB_SPIN(xb_ld(&bar[XB_TOPGEN]) == tg, bar);
            __builtin_amdgcn_fence(__ATOMIC_ACQUIRE, "agent");
            xb_add(&bar[XB_XGEN(b.x)], 1u);
            asm volatile("s_waitcnt vmcnt(0)" ::: "memory");
        } else {
            XB_SPIN(xb_ld(&bar[XB_XGEN(b.x)]) == gen, bar);
            __builtin_amdgcn_fence(__ATOMIC_ACQUIRE, "agent");
            asm volatile("s_waitcnt vmcnt(0)" ::: "memory");
        }
    }
    __syncthreads();
}

struct Args { const float* in[23]; float* out; unsigned char* ws; int ph_lo, ph_hi; };
enum { I_X = 0, I_MEM, I_NMIX, I_WIN, I_RELA, I_T5, I_DLAM, I_SUBLN, I_WOUT, I_NCROSS, I_NMEM, I_WXQ, I_WXKV, I_WXO, I_NFFN, I_WG, I_BG, I_WE, I_BE, I_W1, I_W3, I_W2, I_NFIN };

struct Ctx {
    const __attribute__((address_space(4))) unsigned char* ka;
    float* out; GAS unsigned char* ws;
    LAS unsigned char* lds;
    int tid, lane, wave, gw, ngw;
};
#define WSP(type, off) ((type*)(GAS type*)(C.ws + (off)))
#define CIN(i) ((const float*)*(const GAS float* const __attribute__((address_space(4)))*)(C.ka + 8 * (i)))

DI unsigned cvtpk_rne(float lo, float hi) { unsigned r; asm volatile("v_cvt_pk_bf16_f32 %0, %1, %2" : "=v"(r) : "v"(lo), "v"(hi)); return r; }
DI unsigned pk8(float a, float b, float c, float d) { int r = __builtin_amdgcn_cvt_pk_fp8_f32(a, b, 0, false); r = __builtin_amdgcn_cvt_pk_fp8_f32(c, d, r, true); return (unsigned)r; }
DI float clamp8(float v) { return __builtin_amdgcn_fmed3f(v, -448.f, 448.f); }
constexpr float W8S = 64.f;
template <bool F8 = false> DI void tr_item(const float* src, int ldsrc, int k0, int n0, const float* gk, float nscale, void* dst_, int lddst, int drow0, int lane) {
    bf16_t* dst = (bf16_t*)dst_;
    const int n4 = lane & 15, kg = lane >> 4;
    const float* sp = src + (size_t)(k0 + kg * 16) * ldsrc + n0 + 4 * n4;
    f32x4 v[16];
#pragma unroll
    for (int j = 0; j < 16; ++j) v[j] = __builtin_nontemporal_load((const f32x4*)(sp + (size_t)j * ldsrc));
    float g[16];
    if (gk) {
#pragma unroll
        for (int j4 = 0; j4 < 4; ++j4) { const f32x4 t = *(const f32x4*)(gk + k0 + kg * 16 + 4 * j4); g[4 * j4] = t.x * nscale; g[4 * j4 + 1] = t.y * nscale; g[4 * j4 + 2] = t.z * nscale; g[4 * j4 + 3] = t.w * nscale; }
    } else {
#pragma unroll
        for (int j = 0; j < 16; ++j) g[j] = nscale;
    }
    if constexpr (F8) { unsigned char* dp8 = (unsigned char*)dst_ + (size_t)(drow0 + 4 * n4) * lddst + k0 + kg * 16;
#pragma unroll
        for (int q = 0; q < 4; ++q) { u32x4 o;
#pragma unroll
            for (int c = 0; c < 4; ++c) o[c] = pk8(v[4 * c][q] * g[4 * c], v[4 * c + 1][q] * g[4 * c + 1], v[4 * c + 2][q] * g[4 * c + 2], v[4 * c + 3][q] * g[4 * c + 3]);
            *(u32x4*)(dp8 + (size_t)q * lddst) = o; }
        return; }
    bf16_t* dp = dst + (size_t)(drow0 + 4 * n4) * lddst + k0 + kg * 16;
#pragma unroll
    for (int q = 0; q < 4; ++q)
#pragma unroll
        for (int c = 0; c < 2; ++c) { u32x4 o;
            o.x = cvtpk_rne(v[8 * c][q] * g[8 * c], v[8 * c + 1][q] * g[8 * c + 1]); o.y = cvtpk_rne(v[8 * c + 2][q] * g[8 * c + 2], v[8 * c + 3][q] * g[8 * c + 3]);
            o.z = cvtpk_rne(v[8 * c + 4][q] * g[8 * c + 4], v[8 * c + 5][q] * g[8 * c + 5]); o.w = cvtpk_rne(v[8 * c + 6][q] * g[8 * c + 6], v[8 * c + 7][q] * g[8 * c + 7]);
            *(u32x4*)(dp + (size_t)q * lddst + 8 * c) = o; }
}

DI int t5_bucket(int rel) {
    const int ret = rel > 0 ? 16 : 0; const int n = rel < 0 ? -rel : rel;
    const float nf = (float)(n > 8 ? n : 8);
    int large = 8 + (int)(logf(nf / 8.f) / logf(64.f) * 8.f);
    large = large < 15 ? large : 15;
    return ret + (n < 8 ? n : large);
}

constexpr int LI_WIN = 32 * 96, LI_WOUT = 1024, LI_W13 = NE * 128, LI_W2 = NE * 128, LAYER_ITEMS = LI_WIN + LI_WOUT + LI_W13 + LI_W2;
DI void convert_layer_item(const Ctx& C, int l, int it, int lane) {
    if (it < LI_WIN) { const int kb = it / 96, nb = it % 96, n0 = nb * 64;
        if (l >= L8) { tr_item<true>(CIN(I_WIN) + (size_t)l * D * INW, INW, kb * 64, n0, CIN(I_NMIX) + l * D, W8S, (unsigned char*)(WSP(bf16_t, WS_WIN) + (size_t)l * INW * D), D, n0, lane); return; }
        const float ns = (n0 < 1024) ? SC_A : ((n0 >= 3072 && n0 < 4096) ? SC_B : 1.f);
        tr_item(CIN(I_WIN) + (size_t)l * D * INW, INW, kb * 64, n0, CIN(I_NMIX) + l * D, ns, WSP(bf16_t, WS_WIN) + (size_t)l * INW * D, D, n0, lane); return; }
    it -= LI_WIN;
    if (it < LI_WOUT) { const int kb = it / 32, nb = it % 32;
        if (l >= L8B) { tr_item<true>(CIN(I_WOUT) + (size_t)l * D * D, D, kb * 64, nb * 64, nullptr, W8S, (unsigned char*)(WSP(bf16_t, WS_WOUT) + (size_t)l * D * D), D, nb * 64, lane); return; }
        tr_item(CIN(I_WOUT) + (size_t)l * D * D, D, kb * 64, nb * 64, nullptr, 1.f, WSP(bf16_t, WS_WOUT) + (size_t)l * D * D, D, nb * 64, lane); return; }
    it -= LI_WOUT;
    if (it < LI_W13) { const int le = l * NE + it / 128, r = it % 128, kb = r / 4, nb = r % 4;
        bf16_t* dst = WSP(bf16_t, WS_W13) + (size_t)le * 512 * D; const int dr = (nb >> 1) * 256 + (nb & 1) * 64;
        if (l >= L8M) { unsigned char* d8 = (unsigned char*)(WSP(bf16_t, WS_W13) + (size_t)l * NE * 512 * D) + (size_t)(it / 128) * 512 * D;
            tr_item<true>(CIN(I_W1) + (size_t)le * D * DE, DE, kb * 64, nb * 64, CIN(I_NFFN) + l * D, W8S, d8, D, dr, lane);
            tr_item<true>(CIN(I_W3) + (size_t)le * D * DE, DE, kb * 64, nb * 64, CIN(I_NFFN) + l * D, W8S, d8, D, dr + 128, lane); return; }
        tr_item(CIN(I_W1) + (size_t)le * D * DE, DE, kb * 64, nb * 64, CIN(I_NFFN) + l * D, 1.f, dst, D, dr, lane);
        tr_item(CIN(I_W3) + (size_t)le * D * DE, DE, kb * 64, nb * 64, CIN(I_NFFN) + l * D, 1.f, dst, D, dr + 128, lane); return; }
    it -= LI_W13;
    { const int le = l * NE + it / 128, r = it % 128, kb = r / 32, nb = r % 32;
      if (l >= L8M) { tr_item<true>(CIN(I_W2) + (size_t)le * DE * D, D, kb * 64, nb * 64, nullptr, W8S, (unsigned char*)(WSP(bf16_t, WS_W2) + (size_t)l * NE * D * DE) + (size_t)(it / 128) * D * DE, DE, nb * 64, lane); return; }
      tr_item(CIN(I_W2) + (size_t)le * DE * D, D, kb * 64, nb * 64, nullptr, 1.f, WSP(bf16_t, WS_W2) + (size_t)le * D * DE, DE, nb * 64, lane); }
}
DI void convert_pull(const Ctx& C, int l, int quota, const unsigned* stop) {
    unsigned* qh = WSP(unsigned, WS_CTL) + CW_QH + l;
    for (int n = 0; n < quota; n += 4) {
        unsigned it = 0, st = 0;
        if (C.lane == 0) { if (stop) st = __hip_atomic_load(stop, __ATOMIC_RELAXED, __HIP_MEMORY_SCOPE_AGENT);
                           it = __hip_atomic_fetch_add(qh, 4u, __ATOMIC_RELAXED, __HIP_MEMORY_SCOPE_AGENT); }
        it = (unsigned)__builtin_amdgcn_readfirstlane((int)it); st = (unsigned)__builtin_amdgcn_readfirstlane((int)st);
        if (it >= (unsigned)LAYER_ITEMS) break;
        for (int k = 0; k < 4; ++k) convert_layer_item(C, l, (int)it + k, C.lane);
        if (st != 0u) break;
    }
}
static_assert(LAYER_ITEMS % 4 == 0, "queue batches of 4");
DI void phase_prologue(const Ctx& C) {
    const int gw = C.gw, ngw = C.ngw, lane = C.lane;
    for (int it = gw; it < LAYER_ITEMS; it += ngw) convert_layer_item(C, 0, it, lane);
    for (int it = gw; it < NL * 2048; it += ngw) { const int l = it / 2048, r = it % 2048, kb = r / 64, nb = r % 64;
        tr_item<true>(CIN(I_WXKV) + (size_t)l * D * 4096, 4096, kb * 64, nb * 64, CIN(I_NMEM) + l * D, W8S, WSP(unsigned char, WS_WKV) + (size_t)l * 4096 * D, D, nb * 64, lane); }
    for (int it = gw; it < NL * 1024; it += ngw) { const int l = it / 1024, r = it % 1024, kb = r / 32, nb = r % 32;
        tr_item<true>(CIN(I_WXO) + (size_t)l * D * D, D, kb * 64, nb * 64, nullptr, W8S, WSP(unsigned char, WS_WXO) + (size_t)l * D * D, D, nb * 64, lane); }
    { const size_t n8 = (size_t)NL * D * D / 8; const float* src = CIN(I_WXQ); unsigned char* dst = WSP(unsigned char, WS_WQS);
      for (size_t i = (size_t)gw * 64 + lane; i < n8; i += (size_t)ngw * 64) { const size_t e = i * 8; const int row = (int)((e / D) % D), l = (int)(e / ((size_t)D * D));
          const float sc = CIN(I_NCROSS)[l * D + row] * (SC_X * Q8S); const f32x4 a = __builtin_nontemporal_load((const f32x4*)(src + e)), b = __builtin_nontemporal_load((const f32x4*)(src + e + 4));
          u32x2 o; o.x = pk8(a.x * sc, a.y * sc, a.z * sc, a.w * sc); o.y = pk8(b.x * sc, b.y * sc, b.z * sc, b.w * sc);
          __builtin_nontemporal_store(o, (u32x2*)(dst + e)); } }
    { bf16_t* whi = WSP(bf16_t, WS_WRT); bf16_t* wlo = whi + (size_t)NL * 64 * D;
      for (int i = gw * 64 + lane; i < NL * 64 * D; i += ngw * 64) { const int l = i / (64 * D), rem = i % (64 * D), f = rem >> 9, L = (rem >> 3) & 63, jj = rem & 7;
          const int blk = f & 1, s16 = (f >> 1) & 15, w8 = f >> 5, j = blk * 32 + (L & 31), k = w8 * 256 + s16 * 16 + 8 * (L >> 5) + jj;
          float w = 0.f;
          if (j < 36) w = (j < 4 ? CIN(I_WG)[((size_t)l * D + k) * 4 + j] : CIN(I_WE)[((size_t)l * D + k) * 32 + (j - 4)]) * CIN(I_NFFN)[l * D + k];
          const unsigned h = f2bf(w); whi[i] = (bf16_t)h; wlo[i] = (bf16_t)f2bf(w - __uint_as_float(h << 16)); } }
    { bf16_t* xb = WSP(bf16_t, WS_XB); float* part = WSP(float, WS_PART);
      for (int row = gw; row < T + MT; row += ngw) {
          const bool isx = row < T; const int rr = isx ? row : row - T;
          const float* src = (isx ? CIN(I_X) : CIN(I_MEM)) + (size_t)rr * D; bf16_t* dst = (isx ? xb : WSP(bf16_t, WS_MEMB)) + (size_t)rr * D;
          float ss = 0.f; f32x4 vv[8];
#pragma unroll
          for (int j = 0; j < 8; ++j) vv[j] = __builtin_nontemporal_load((const f32x4*)(src + j * 256 + lane * 4));
          __builtin_amdgcn_sched_barrier(0);
#pragma unroll
          for (int j = 0; j < 8; ++j) { const f32x4 v = vv[j];
              u32x2 o; o.x = pk2(v.x, v.y); o.y = pk2(v.z, v.w);
              if (isx) __builtin_nontemporal_store(o, (u32x2*)(dst + j * 256 + lane * 4));
              else *(unsigned*)(WSP(unsigned char, WS_MEMB) + (size_t)rr * D + j * 256 + lane * 4) = pk8(clamp8(v.x), clamp8(v.y), clamp8(v.z), clamp8(v.w));
              const float a = bf2f((bf16_t)(o.x & 0xffff)), b = bf2f((bf16_t)(o.x >> 16)), c = bf2f((bf16_t)(o.y & 0xffff)), d = bf2f((bf16_t)(o.y >> 16));
              ss += (a * a + b * b) + (c * c + d * d); }
          ss = wave_sum(ss, C.lane);
          if (isx) { if (lane < 32) part[(size_t)rr * 32 + lane] = lane == 0 ? ss : 0.f; }
          else if (lane == 0) WSP(float, WS_RMEM)[rr] = rsqrtf(ss * (1.f / D) + EPS);
      } }
    if (blockIdx.x == 0) {
        float* tb = WSP(float, WS_TABB); float* ta = WSP(float, WS_TABA);
        for (int i = C.tid; i < 8 * TABB_N; i += NTHREADS) { const int h = i / TABB_N, idx = i % TABB_N; const int rel = idx - TABB_OFF;
            tb[i] = (rel <= 63) ? CIN(I_T5)[t5_bucket(rel) * 8 + h] * LOG2E : 0.f; }
        for (int i = C.tid; i < NL * 8 * TABA_N; i += NTHREADS) { const int idx = i % TABA_N, h = (i / TABA_N) % 8, l = i / (8 * TABA_N); int rel = idx - TABA_OFF; rel = rel > 128 ? 128 : (rel < -128 ? -128 : rel);
            ta[i] = CIN(I_RELA)[((size_t)l * 257 + (rel + 128)) * 8 + h] * LOG2E; }
        if (C.wave < NL) { const int l = C.wave; const float* lv = CIN(I_DLAM) + l * 256;
            const float s1 = wave_sum(lv[lane] * lv[64 + lane], C.lane), s2 = wave_sum(lv[128 + lane] * lv[192 + lane], C.lane);
            if (lane == 0) WSP(float, WS_LAM)[l] = expf(s1) - expf(s2) + (0.8f - 0.6f * expf(-0.3f * (float)l)); }
    }
}

DI void phase_router(const Ctx& C, int l) {
    const bf16_t* xb = WSP(bf16_t, WS_XB); const float* part = WSP(float, WS_PART);
    const bf16_t* whi = WSP(bf16_t, WS_WRT) + (size_t)l * 64 * D; const bf16_t* wlo = whi + (size_t)NL * 64 * D;
    unsigned* cnt = WSP(unsigned, WS_CTL) + CW_CNT + l * NE * CNT_STRIDE;
    int* ltok = WSP(int, WS_LTOK); float* lw = WSP(float, WS_LW); float* lr = WSP(float, WS_LR);
    const int lane = C.lane, wid = C.wave, r32 = lane & 31, hi = lane >> 5;
    LAS float* red = (LAS float*)C.lds;
    LAS float* lg = (LAS float*)(C.lds + 65536);
    volatile LAS unsigned* lcnt = (volatile LAS unsigned*)(C.lds + 65536 + 8192); volatile LAS unsigned* gbase = lcnt + 32;
    for (int tb = (int)blockIdx.x; tb < T / 32; tb += (int)gridDim.x) {
        const int t0 = tb * 32, k0 = wid * 256;
        f32x16 a0 = {}, a1 = {};
        const char* xp = (const char*)(xb + (size_t)t0 * D + k0); unsigned xo = (unsigned)(r32 * D + 8 * hi) * 2u;
        const char* wh = (const char*)(whi + (size_t)(wid * 32) * 512); const char* wl = (const char*)(wlo + (size_t)(wid * 32) * 512); unsigned wo = (unsigned)lane * 16u;
        bf16x8 xf[3][2], fh[3][4], fl[3][4];
#define RT_LOAD(bf, s2) do { asm volatile("" : "+v"(xo), "+v"(wo)); _Pragma("unroll") for (int q = 0; q < 2; ++q) xf[bf][q] = *(const bf16x8*)(xp + 32 * ((s2) + q) + xo); \
            _Pragma("unroll") for (int q = 0; q < 4; ++q) { fh[bf][q] = *(const bf16x8*)(wh + (2 * (s2) + q) * 1024 + wo); fl[bf][q] = *(const bf16x8*)(wl + (2 * (s2) + q) * 1024 + wo); } __builtin_amdgcn_sched_barrier(0); } while (0)
#define RT_MMA(bf) do { _Pragma("unroll") for (int q = 0; q < 2; ++q) { \
                a0 = MFMA32(fh[bf][2 * q], xf[bf][q], a0);     a0 = MFMA32(fl[bf][2 * q], xf[bf][q], a0); \
                a1 = MFMA32(fh[bf][2 * q + 1], xf[bf][q], a1); a1 = MFMA32(fl[bf][2 * q + 1], xf[bf][q], a1); } __builtin_amdgcn_sched_barrier(0); } while (0)
        RT_LOAD(0, 0); RT_LOAD(1, 2);
        RT_LOAD(2, 4);  RT_MMA(0);
        RT_LOAD(0, 6);  RT_MMA(1);
        RT_LOAD(1, 8);  RT_MMA(2);
        RT_LOAD(2, 10); RT_MMA(0);
        RT_LOAD(0, 12); RT_MMA(1);
        RT_LOAD(1, 14); RT_MMA(2);
        RT_MMA(0); RT_MMA(1);
#undef RT_LOAD
#undef RT_MMA
#pragma unroll
        for (int i = 0; i < 16; ++i) red[(wid * 36 + crow(i, hi)) * 32 + r32] = a0[i];
        if (hi == 0) {
#pragma unroll
            for (int i = 0; i < 4; ++i) red[(wid * 36 + 32 + i) * 32 + r32] = a1[i];
        }
        AT_BAR();
        if (wid == 0) {
            if (lane < 32) lcnt[lane] = 0u;
            const f32x4* pp = (const f32x4*)(part + (size_t)(t0 + r32) * 32); float ps = 0.f;
#pragma unroll
            for (int q = 0; q < 8; ++q) { const f32x4 v = pp[q]; ps += (v.x + v.y) + (v.z + v.w); }
            const float rs = rsqrtf(ps * (1.f / D) + EPS);
#pragma unroll
            for (int oo = 0; oo < 18; ++oo) { const int o = hi * 18 + oo; float sacc = 0.f;
#pragma unroll
                for (int w = 0; w < 8; ++w) sacc += red[(w * 36 + o) * 32 + r32];
                lg[r32 * 40 + o] = sacc * rs + (o < 4 ? CIN(I_BG)[l * 4 + o] : CIN(I_BE)[l * 32 + (o - 4)]); }
            LDS_WAIT();
            if (hi == 0) {
                const LAS float* my = lg + r32 * 40; const int t = t0 + r32;
                const float g0 = my[0], g1 = my[1], g2 = my[2], g3 = my[3];
                int gs = 0; float gm = g0; if (g1 > gm) { gm = g1; gs = 1; } if (g2 > gm) { gm = g2; gs = 2; } if (g3 > gm) { gm = g3; gs = 3; }
                const float gate = 1.f / (expf(g0 - gm) + expf(g1 - gm) + expf(g2 - gm) + expf(g3 - gm));
                float v0 = -3.0e38f, v1 = -3.0e38f; int i0 = 0, i1 = 0;
#pragma unroll
                for (int i = 0; i < 8; ++i) { const float v = my[4 + gs * 8 + i];
                    if (v > v0) { v1 = v0; i1 = i0; v0 = v; i0 = i; } else if (v > v1) { v1 = v; i1 = i; } }
                const float e = expf(v1 - v0), w0 = gate / (1.f + e), w1 = gate * e / (1.f + e);
                const int ea = gs * 8 + i0, eb = gs * 8 + i1;
                const unsigned la = __hip_atomic_fetch_add((LAS unsigned*)lcnt + ea, 1u, __ATOMIC_RELAXED, __HIP_MEMORY_SCOPE_WORKGROUP), lb = __hip_atomic_fetch_add((LAS unsigned*)lcnt + eb, 1u, __ATOMIC_RELAXED, __HIP_MEMORY_SCOPE_WORKGROUP);
                LDS_WAIT();
                { const unsigned mine = lcnt[r32]; unsigned gb = 0u; if (mine) gb = atomicAdd(&cnt[r32 * CNT_STRIDE], mine); gbase[r32] = gb; }
                LDS_WAIT();
                const unsigned pa = gbase[ea] + la, pb = gbase[eb] + lb;
                ltok[(size_t)ea * T + pa] = t * 2;     lw[(size_t)ea * T + pa] = w0; lr[(size_t)ea * T + pa] = rs;
                ltok[(size_t)eb * T + pb] = t * 2 + 1; lw[(size_t)eb * T + pb] = w1; lr[(size_t)eb * T + pb] = rs;
            }
        }
        AT_BAR();
    }
}
DI void phase_combine(const Ctx& C, int l) {
    bf16_t* xb = WSP(bf16_t, WS_XB); const bf16_t* Y = WSP(bf16_t, WS_Y); float* part = WSP(float, WS_PART);
    for (int row = C.gw; row < T; row += C.ngw) {
        float xv[32]; float ss = 0.f;
#pragma unroll
        for (int j = 0; j < 4; ++j) { const size_t o = (size_t)row * D + j * 512 + C.lane * 8;
            const u32x4 a = __builtin_nontemporal_load((const u32x4*)(xb + o)); const u32x2 y0 = __builtin_nontemporal_load((const u32x2*)((const unsigned char*)Y + o)), y1 = __builtin_nontemporal_load((const u32x2*)((const unsigned char*)Y + (size_t)T * D + o));
#pragma unroll
            for (int h2 = 0; h2 < 2; ++h2) { const int w0 = (int)y0[h2], w1 = (int)y1[h2];
                const auto l0 = __builtin_amdgcn_cvt_pk_f32_fp8(w0, false), u0 = __builtin_amdgcn_cvt_pk_f32_fp8(w0, true), l1 = __builtin_amdgcn_cvt_pk_f32_fp8(w1, false), u1 = __builtin_amdgcn_cvt_pk_f32_fp8(w1, true);
                xv[j * 8 + 4 * h2]     = __uint_as_float(a[2 * h2] << 16)               + (l0[0] + l1[0]) * (1.f / Y8S);
                xv[j * 8 + 4 * h2 + 1] = __uint_as_float(a[2 * h2] & 0xffff0000u)       + (l0[1] + l1[1]) * (1.f / Y8S);
                xv[j * 8 + 4 * h2 + 2] = __uint_as_float(a[2 * h2 + 1] << 16)           + (u0[0] + u1[0]) * (1.f / Y8S);
                xv[j * 8 + 4 * h2 + 3] = __uint_as_float(a[2 * h2 + 1] & 0xffff0000u)   + (u0[1] + u1[1]) * (1.f / Y8S); } }
        if (l == NL - 1) {
#pragma unroll
            for (int i = 0; i < 32; ++i) ss += xv[i] * xv[i];
            const float rs = rsqrtf(wave_sum(ss, C.lane) * (1.f / D) + EPS);
#pragma unroll
            for (int j = 0; j < 4; ++j) { const int col = j * 512 + C.lane * 8; const f32x4 g0 = *(const f32x4*)(CIN(I_NFIN) + col), g1 = *(const f32x4*)(CIN(I_NFIN) + col + 4);
                f32x4 o0, o1; o0.x = xv[j * 8] * rs * g0.x; o0.y = xv[j * 8 + 1] * rs * g0.y; o0.z = xv[j * 8 + 2] * rs * g0.z; o0.w = xv[j * 8 + 3] * rs * g0.w;
                o1.x = xv[j * 8 + 4] * rs * g1.x; o1.y = xv[j * 8 + 5] * rs * g1.y; o1.z = xv[j * 8 + 6] * rs * g1.z; o1.w = xv[j * 8 + 7] * rs * g1.w;
                *(f32x4*)(C.out + (size_t)row * D + col) = o0; *(f32x4*)(C.out + (size_t)row * D + col + 4) = o1; }
        } else {
#pragma unroll
            for (int j = 0; j < 4; ++j) { u32x4 o;
#pragma unroll
                for (int q = 0; q < 4; ++q) { o[q] = pk2(xv[j * 8 + 2 * q], xv[j * 8 + 2 * q + 1]);
                    const float a = __uint_as_float(o[q] << 16), b = __uint_as_float(o[q] & 0xffff0000u); ss += a * a + b * b; }
                __builtin_nontemporal_store(o, (u32x4*)(xb + (size_t)row * D + j * 512 + C.lane * 8));
                if (l + 1 >= L8) { u32x2 e; e.x = pk8(clamp8(xv[j * 8]), clamp8(xv[j * 8 + 1]), clamp8(xv[j * 8 + 2]), clamp8(xv[j * 8 + 3])); e.y = pk8(clamp8(xv[j * 8 + 4]), clamp8(xv[j * 8 + 5]), clamp8(xv[j * 8 + 6]), clamp8(xv[j * 8 + 7]));
                __builtin_nontemporal_store(e, (u32x2*)(WSP(unsigned char, WS_X8) + (size_t)row * D + j * 512 + C.lane * 8)); } }
            ss = wave_sum(ss, C.lane);
            if (C.lane < 32) part[(size_t)row * 32 + C.lane] = C.lane == 0 ? ss : 0.f;
        }
    }
}

typedef short s16x4 __attribute__((ext_vector_type(4)));
#define AT_KSWZ(row, colB) ((row) * 256 + ((colB) ^ (((row) & 7) << 4)))
DI int at_v_rd_base(int lane) { return ((lane & 3) << 3) | (((lane >> 2) & 3) << 6) | (((lane >> 4) & 1) << 5) | (((lane >> 5) & 1) << 8); }
template <int OFF> DI s16x4 at_tr_read(int vb) { s16x4 r; asm volatile("ds_read_b64_tr_b16 %0, %1 offset:%2" : "=&v"(r) : "v"(vb), "i"(OFF) : "memory"); return r; }
DI unsigned at_cvtpk(float lo, float hi) { unsigned r; asm volatile("v_cvt_pk_bf16_f32 %0, %1, %2" : "=v"(r) : "v"(lo), "v"(hi)); return r; }
constexpr float AT_THR = 8.f;

template <int KS> DI void at_qk(f32x16& p0, f32x16& p1, LAS const unsigned char* Kt, int mapB, const bf16x8 (&qr)[8], float init, int r32, int hi) {
#pragma unroll
    for (int i = 0; i < 16; ++i) { p0[i] = init; p1[i] = init; }
    bf16x8 kb[KS][2];
#pragma unroll
    for (int d0 = 0; d0 < KS; ++d0) { const int cb = mapB + (d0 * 16 + hi * 8) * 2;
        kb[d0][0] = *(const LAS bf16x8*)(Kt + AT_KSWZ(r32, cb)); kb[d0][1] = *(const LAS bf16x8*)(Kt + AT_KSWZ(32 + r32, cb)); }
    __builtin_amdgcn_sched_barrier(0);
#pragma unroll
    for (int d0 = 0; d0 < KS; ++d0) { p0 = MFMA32(kb[d0][0], qr[d0], p0); p1 = MFMA32(kb[d0][1], qr[d0], p1); }
}
DI float at_softmax(f32x16& p0, f32x16& p1, float& m_run, bool first, bool nearb, LAS const float* tabp, int lane) {
    if (nearb) {
#pragma unroll
        for (int i = 0; i < 16; ++i) { p0[i] += tabp[8 * (i >> 2) + (i & 3)]; p1[i] += tabp[32 + 8 * (i >> 2) + (i & 3)]; }
    }
    float mx = p0[0];
#pragma unroll
    for (int i = 1; i < 16; ++i) mx = fmaxf(mx, p0[i]);
#pragma unroll
    for (int i = 0; i < 16; ++i) mx = fmaxf(mx, p1[i]);
    float alpha = 1.f;
    if (first || !__all(mx <= AT_THR)) {
        mx = max_x32(mx, lane);
        const float dl = first ? mx : fmaxf(mx, 0.f);
        alpha = first ? 1.f : __builtin_amdgcn_exp2f(-dl); m_run += dl;
#pragma unroll
        for (int i = 0; i < 16; ++i) { p0[i] -= dl; p1[i] -= dl; }
    }
#pragma unroll
    for (int i = 0; i < 16; ++i) p0[i] = __builtin_amdgcn_exp2f(p0[i]);
#pragma unroll
    for (int i = 0; i < 16; ++i) p1[i] = __builtin_amdgcn_exp2f(p1[i]);
    return alpha;
}
DI bf16x8 at_pack(const f32x16& p, int s8) {
    u32x4 w; w.x = at_cvtpk(p[s8], p[s8 + 1]); w.y = at_cvtpk(p[s8 + 2], p[s8 + 3]); w.z = at_cvtpk(p[s8 + 4], p[s8 + 5]); w.w = at_cvtpk(p[s8 + 6], p[s8 + 7]);
    return __builtin_bit_cast(bf16x8, w);
}
template <int D0> DI void at_pv_block(f32x16 (&o)[4], int vb, const bf16x8 (&pf)[4]) {
    const s16x4 l0 = at_tr_read<D0 * 512 + 0 * 4096>(vb), h0 = at_tr_read<D0 * 512 + 0 * 4096 + 2048>(vb), l1 = at_tr_read<D0 * 512 + 1 * 4096>(vb), h1 = at_tr_read<D0 * 512 + 1 * 4096 + 2048>(vb);
    const s16x4 l2 = at_tr_read<D0 * 512 + 2 * 4096>(vb), h2 = at_tr_read<D0 * 512 + 2 * 4096 + 2048>(vb), l3 = at_tr_read<D0 * 512 + 3 * 4096>(vb), h3 = at_tr_read<D0 * 512 + 3 * 4096 + 2048>(vb);
    asm volatile("s_waitcnt lgkmcnt(0)" ::: "memory"); __builtin_amdgcn_sched_barrier(0);
#define AT_PK(L, H) (bf16x8){L[0], L[1], L[2], L[3], H[0], H[1], H[2], H[3]}
    o[D0] = MFMA32(AT_PK(l0, h0), pf[0], o[D0]); o[D0] = MFMA32(AT_PK(l1, h1), pf[1], o[D0]); o[D0] = MFMA32(AT_PK(l2, h2), pf[2], o[D0]); o[D0] = MFMA32(AT_PK(l3, h3), pf[3], o[D0]);
#undef AT_PK
}

DI void at_store_rows8(const unsigned (&pk)[4][4], LAS unsigned char* wst, unsigned char* out_row0, int r32, int hi, int lane) {
#pragma unroll
    for (int d0 = 0; d0 < 4; ++d0)
#pragma unroll
        for (int gq = 0; gq < 4; ++gq) *(LAS unsigned*)(wst + r32 * 144 + 32 * d0 + 8 * gq + 4 * hi) = pk[d0][gq];
    LDS_WAIT();
#pragma unroll
    for (int k = 0; k < 4; ++k) { const int idx = k * 64 + lane, row = idx >> 3, c = idx & 7;
        const u32x4 v = *(const LAS u32x4*)(wst + row * 144 + c * 16);
        __builtin_nontemporal_store(v, (u32x4*)(out_row0 + (size_t)row * D + c * 16)); }
}
DI void at_store_rows(const u32x2 (&pk)[4][4], LAS unsigned char* wst, bf16_t* out_row0  , int r32, int hi, int lane) {
#pragma unroll
    for (int d0 = 0; d0 < 4; ++d0)
#pragma unroll
        for (int gq = 0; gq < 4; ++gq) *(LAS u32x2*)(wst + r32 * 272 + (32 * d0 + 8 * gq + 4 * hi) * 2) = pk[d0][gq];
    LDS_WAIT();
#pragma unroll
    for (int k = 0; k < 8; ++k) { const int idx = k * 64 + lane, row = idx >> 4, c = idx & 15;
        const u32x4 v = *(const LAS u32x4*)(wst + row * 272 + c * 16);
        __builtin_nontemporal_store(v, (u32x4*)(out_row0 + (size_t)row * D + c * 8)); }
}
DI void at_stage1(LAS unsigned char* lds, const char* projb, int kcolB, int vcolB, int kt, int slot, int wid, unsigned lb0, unsigned lb1) {
    const int kv = wid >> 2, sub0 = (wid & 3) * 4;
    LAS unsigned char* dst = lds + slot * 32768 + kv * 16384 + sub0 * 1024;
    const char* tb = projb + (size_t)kt * 64 * (INW * 2) + (kv ? vcolB : kcolB);
#pragma unroll
    for (int n = 0; n < 4; ++n) { const int sub = sub0 + n;
        const size_t U = kv ? (size_t)((sub >> 1) * 8) * (INW * 2) + (size_t)((sub & 1) * 128) : (size_t)(sub * 4) * (INW * 2);
        __builtin_amdgcn_global_load_lds((const unsigned*)(tb + U + ((n & 1) ? lb1 : lb0)), (LAS unsigned*)(dst + n * 1024), 16, 0, 0); }
}
DI void attn_unit_diff(const Ctx& C, int l, int b, int h, int j) {
    constexpr int KS = 4;
    int lane_ = C.lane; asm volatile("" : "+v"(lane_));
    const int lane = lane_, wid = C.wave, g = wid >> 2, wq = wid & 3, r32 = lane & 31, hi = lane >> 5;
    const int qcol = 3072 + h * 128 + g * 64, kcolB = (4096 + h * 128) * 2, vcolB = (5120 + h * 128) * 2;
    const bf16_t* proj = WSP(bf16_t, WS_PROJ);
    const size_t rowb = (size_t)b * SEQ;
    const char* projb = (const char*)(proj + rowb * INW);
    const int nt = 2 * j + 2;
    const int cw = 2 * j + (wq >> 1), q0w = j * 128 + wq * 32, qpos = q0w + r32;
    const float* tabg = WSP(float, WS_TABB) + h * TABB_N;
    LAS float* tabl = (LAS float*)(C.lds + 131072);
    AT_BAR();
    for (int i = wid * 64 + lane; i < TABB_N; i += NTHREADS) tabl[i] = tabg[i];
    bf16x8 qr[8];
    { const bf16_t* qp = proj + (rowb + qpos) * INW + qcol + 8 * hi;
#pragma unroll
      for (int s = 0; s < KS; ++s) qr[s] = *(const bf16x8*)(qp + 16 * s); }
    unsigned lb0, lb1;
    { const int kv = wid >> 2;
      if (kv == 0) { const int rl = lane >> 4, cp = lane & 15; lb0 = (unsigned)(rl * (INW * 2) + ((cp ^ (rl & 7)) * 16)); lb1 = (unsigned)(rl * (INW * 2) + ((cp ^ ((4 + rl) & 7)) * 16)); }
      else { lb0 = (unsigned)(((lane & 31) >> 2) * (INW * 2) + ((lane >> 5) * 32 + (lane & 3) * 8) * 2); lb1 = lb0; } }
    at_stage1(C.lds, projb, kcolB, vcolB, 0, 0, wid, lb0, lb1);
    at_stage1(C.lds, projb, kcolB, vcolB, 1, 1, wid, lb0, lb1);
    f32x16 o[4], ol = {}; float m_run = 0.f; bool first = true;
#pragma unroll
    for (int d0 = 0; d0 < 4; ++d0) o[d0] = f32x16{};
    const bf16x8 ones = {16256, 16256, 16256, 16256, 16256, 16256, 16256, 16256};
    asm volatile("s_waitcnt vmcnt(4) lgkmcnt(0)\n\ts_barrier" ::: "memory");
    const float cfar = tabl[0];
    const int vrd = at_v_rd_base(lane);
    for (int sd = 0; sd < nt; ++sd) {
        const int slot = sd % 3;
        const bool staged = sd + 2 < nt;
        if (staged) at_stage1(C.lds, projb, kcolB, vcolB, sd + 2, (sd + 2) % 3, wid, lb0, lb1);
        if (sd <= cw) {
            LAS const unsigned char* Kt = C.lds + slot * 32768;
            const int vb = (int)(size_t)(Kt + 16384) + vrd;
            const bool nearb = (sd * 64 + 63 - q0w) > -305;
            LAS const float* tabp = tabl + (sd * 64 - qpos + TABB_OFF + 4 * hi);
            f32x16 p0, p1;
            at_qk<KS>(p0, p1, Kt, g * 128, qr, (nearb ? 0.f : cfar) - m_run, r32, hi);
            const float alpha = at_softmax(p0, p1, m_run, first, nearb, tabp, lane);
            first = false;
            if (__any(alpha != 1.f)) {
                ol[0] *= alpha;
#pragma unroll
                for (int d0 = 0; d0 < 4; ++d0)
#pragma unroll
                    for (int i = 0; i < 16; ++i) o[d0][i] *= alpha;
            }
            bf16x8 pf[4];
            pf[0] = at_pack(p0, 0); pf[1] = at_pack(p0, 8); pf[2] = at_pack(p1, 0); pf[3] = at_pack(p1, 8);
            ol = MFMA32(ones, pf[0], ol); ol = MFMA32(ones, pf[1], ol); ol = MFMA32(ones, pf[2], ol); ol = MFMA32(ones, pf[3], ol);
            at_pv_block<0>(o, vb, pf); at_pv_block<1>(o, vb, pf); at_pv_block<2>(o, vb, pf); at_pv_block<3>(o, vb, pf);
        }
        if (staged) asm volatile("s_waitcnt vmcnt(4) lgkmcnt(0)\n\ts_barrier" ::: "memory");
        else        asm volatile("s_waitcnt vmcnt(0) lgkmcnt(0)\n\ts_barrier" ::: "memory");
    }
    const float inv = 1.f / ol[0];
    LAS float* cmb = (LAS float*)C.lds + (size_t)wq * (64 * 64);
    if (g == 1) {
#pragma unroll
        for (int d0 = 0; d0 < 4; ++d0)
#pragma unroll
            for (int i = 0; i < 16; ++i) cmb[(d0 * 16 + i) * 64 + lane] = o[d0][i] * inv;
    }
    AT_BAR();
    if (g == 0) {
        const float lam = WSP(float, WS_LAM)[l]; float ss = 0.f;
#pragma unroll
        for (int d0 = 0; d0 < 4; ++d0)
#pragma unroll
            for (int i = 0; i < 16; ++i) { const float v = o[d0][i] * inv - lam * cmb[(d0 * 16 + i) * 64 + lane]; o[d0][i] = v; ss += v * v; }
        ss = sum_x32(ss, lane);
        const float lam_init = 0.8f - 0.6f * expf(-0.3f * (float)l);
        const float rn = rsqrtf(ss * (1.f / 128.f) + EPS) * (1.f - lam_init);
        const float* sg = CIN(I_SUBLN) + l * 128;
        if (l >= L8B) { unsigned pk8v[4][4];
#pragma unroll
            for (int d0 = 0; d0 < 4; ++d0)
#pragma unroll
                for (int gq = 0; gq < 4; ++gq) { const int d = 32 * d0 + 8 * gq + 4 * hi; const f32x4 gv = *(const f32x4*)(sg + d);
                    pk8v[d0][gq] = pk8(clamp8(o[d0][4 * gq] * rn * gv.x), clamp8(o[d0][4 * gq + 1] * rn * gv.y), clamp8(o[d0][4 * gq + 2] * rn * gv.z), clamp8(o[d0][4 * gq + 3] * rn * gv.w)); }
            at_store_rows8(pk8v, C.lds + 65536 + wq * 8704, WSP(unsigned char, WS_MIX) + (rowb + q0w) * D + 1024 + h * 128, r32, hi, lane);
        } else {
        u32x2 pk[4][4];
#pragma unroll
        for (int d0 = 0; d0 < 4; ++d0)
#pragma unroll
            for (int gq = 0; gq < 4; ++gq) { const int d = 32 * d0 + 8 * gq + 4 * hi; const f32x4 gv = *(const f32x4*)(sg + d);
                pk[d0][gq].x = at_cvtpk(o[d0][4 * gq] * rn * gv.x, o[d0][4 * gq + 1] * rn * gv.y); pk[d0][gq].y = at_cvtpk(o[d0][4 * gq + 2] * rn * gv.z, o[d0][4 * gq + 3] * rn * gv.w); }
        at_store_rows(pk, C.lds + 65536 + wq * 8704, WSP(bf16_t, WS_MIX) + (rowb + q0w) * D + 1024 + h * 128, r32, hi, lane); }
    }
}
DI void attn_unit_band(const Ctx& C, int l, int b, int h, int qt) {
    constexpr int KS = 8;
    int lane_ = C.lane; asm volatile("" : "+v"(lane_));
    const int lane = lane_, wid = C.wave, r32 = lane & 31, hi = lane >> 5;
    const int qcol = h * 128, kcolB = (1024 + h * 128) * 2, vcolB = (2048 + h * 128) * 2;
    const bf16_t* proj = WSP(bf16_t, WS_PROJ);
    const size_t rowb = (size_t)b * SEQ;
    const char* projb = (const char*)(proj + rowb * INW);
    const int kt_hi = 4 * qt + 3, kt_lo = qt >= 2 ? 4 * qt - 8 : 0, nt = kt_hi - kt_lo + 1;
    const int cw = 4 * qt + (wid >> 1), q0w = qt * 256 + wid * 32, qpos = q0w + r32;
    const float* tabg = WSP(float, WS_TABA) + (l * 8 + h) * TABA_N;
    LAS float* tabl = (LAS float*)(C.lds + 131072);
    AT_BAR();
    for (int i = wid * 64 + lane; i < TABA_N; i += NTHREADS) tabl[i] = tabg[i];
    bf16x8 qr[8];
    { const bf16_t* qp = proj + (rowb + qpos) * INW + qcol + 8 * hi;
#pragma unroll
      for (int s = 0; s < KS; ++s) qr[s] = *(const bf16x8*)(qp + 16 * s); }
    unsigned lb0, lb1;
    { const int kv = wid >> 2;
      if (kv == 0) { const int rl = lane >> 4, cp = lane & 15; lb0 = (unsigned)(rl * (INW * 2) + ((cp ^ (rl & 7)) * 16)); lb1 = (unsigned)(rl * (INW * 2) + ((cp ^ ((4 + rl) & 7)) * 16)); }
      else { lb0 = (unsigned)(((lane & 31) >> 2) * (INW * 2) + ((lane >> 5) * 32 + (lane & 3) * 8) * 2); lb1 = lb0; } }
    at_stage1(C.lds, projb, kcolB, vcolB, kt_lo, 0, wid, lb0, lb1);
    at_stage1(C.lds, projb, kcolB, vcolB, kt_lo + 1, 1, wid, lb0, lb1);
    f32x16 o[4], ol = {}; float m_run = 0.f; bool first = true;
#pragma unroll
    for (int d0 = 0; d0 < 4; ++d0) o[d0] = f32x16{};
    const bf16x8 ones = {16256, 16256, 16256, 16256, 16256, 16256, 16256, 16256};
    asm volatile("s_waitcnt vmcnt(4) lgkmcnt(0)\n\ts_barrier" ::: "memory");
    const float cfar = tabl[0];
    const int vrd = at_v_rd_base(lane);
    for (int sd = 0; sd < nt; ++sd) {
        const int slot = sd % 3, kt = kt_lo + sd;
        const bool staged = sd + 2 < nt;
        if (staged) at_stage1(C.lds, projb, kcolB, vcolB, kt + 2, (sd + 2) % 3, wid, lb0, lb1);
        if (kt <= cw && kt >= cw - 8) {
            LAS const unsigned char* Kt = C.lds + slot * 32768;
            const int vb = (int)(size_t)(Kt + 16384) + vrd;
            const bool nearb = (kt * 64 + 63 - q0w) > -128;
            LAS const float* tabp = tabl + (kt * 64 - qpos + TABA_OFF + 4 * hi);
            f32x16 p0, p1;
            at_qk<KS>(p0, p1, Kt, 0, qr, (nearb ? 0.f : cfar) - m_run, r32, hi);
            const float alpha = at_softmax(p0, p1, m_run, first, nearb, tabp, lane);
            first = false;
            if (__any(alpha != 1.f)) {
                ol[0] *= alpha;
#pragma unroll
                for (int d0 = 0; d0 < 4; ++d0)
#pragma unroll
                    for (int i = 0; i < 16; ++i) o[d0][i] *= alpha;
            }
            bf16x8 pf[4];
            pf[0] = at_pack(p0, 0); pf[1] = at_pack(p0, 8); pf[2] = at_pack(p1, 0); pf[3] = at_pack(p1, 8);
            ol = MFMA32(ones, pf[0], ol); ol = MFMA32(ones, pf[1], ol); ol = MFMA32(ones, pf[2], ol); ol = MFMA32(ones, pf[3], ol);
            at_pv_block<0>(o, vb, pf); at_pv_block<1>(o, vb, pf); at_pv_block<2>(o, vb, pf); at_pv_block<3>(o, vb, pf);
        }
        if (staged) asm volatile("s_waitcnt vmcnt(4) lgkmcnt(0)\n\ts_barrier" ::: "memory");
        else        asm volatile("s_waitcnt vmcnt(0) lgkmcnt(0)\n\ts_barrier" ::: "memory");
    }
    const float inv = 1.f / ol[0];
    if (l >= L8B) { unsigned pk8v[4][4];
#pragma unroll
        for (int d0 = 0; d0 < 4; ++d0)
#pragma unroll
            for (int gq = 0; gq < 4; ++gq) pk8v[d0][gq] = pk8(clamp8(o[d0][4 * gq] * inv), clamp8(o[d0][4 * gq + 1] * inv), clamp8(o[d0][4 * gq + 2] * inv), clamp8(o[d0][4 * gq + 3] * inv));
        at_store_rows8(pk8v, C.lds + wid * 8704, WSP(unsigned char, WS_MIX) + (rowb + q0w) * D + h * 128, r32, hi, lane);
    } else {
    u32x2 pk[4][4];
#pragma unroll
    for (int d0 = 0; d0 < 4; ++d0)
#pragma unroll
        for (int gq = 0; gq < 4; ++gq) { pk[d0][gq].x = at_cvtpk(o[d0][4 * gq] * inv, o[d0][4 * gq + 1] * inv); pk[d0][gq].y = at_cvtpk(o[d0][4 * gq + 2] * inv, o[d0][4 * gq + 3] * inv); }
    at_store_rows(pk, C.lds + wid * 8704, WSP(bf16_t, WS_MIX) + (rowb + q0w) * D + h * 128, r32, hi, lane); }
}
DI void phase_attn(const Ctx& C, int l) {
    const int G = (int)gridDim.x, cb = (int)blockIdx.x;
    const int vc = (G == 256) ? ((cb & 7) * 32 + (cb >> 3)) : cb;
    for (int pc = vc; pc < 256; pc += G) { const int bh = pc >> 4, jp = pc & 15;
        attn_unit_diff(C, l, bh >> 3, bh & 7, 31 - jp); attn_unit_diff(C, l, bh >> 3, bh & 7, jp); }
    for (int ia = vc; ia < 256; ia += G) { const int bh = ia >> 4; attn_unit_band(C, l, bh >> 3, bh & 7, ia & 15); }
    AT_BAR();
}

namespace pg8 {
constexpr int BM = 256, BK = 64, HALF = 128, HTB = HALF * BK * 2, STAGE_BYTES = 8 * HTB;
__host__ __device__ __forceinline__ int lds_byte(int r, int c) { const int st = (r >> 4) * 2 + (c >> 5), rr = r & 15, cc = c & 31, ob = rr * 64 + cc * 2; return st * 1024 + (ob ^ (((ob >> 9) & 1) << 5)); }
__host__ __device__ __forceinline__ void stage_rc(int b, int& R, int& C) { const int st = b / 1024, sb = b % 1024, swz = sb ^ (((sb >> 9) & 1) << 5); R = (st >> 1) * 16 + swz / 64; C = (st & 1) * 32 + (swz % 64) / 2; }
__host__ __device__ __forceinline__ int perm32(int rho) { const int n = rho >> 4, i = rho & 15; return 8 * (i >> 2) + 4 * n + (i & 3); }
struct Unit { const char* A; const char* B; int pm, pn, z, n, base; };
__device__ __forceinline__ unsigned cvt_pk_bf16(float lo, float hi) { unsigned r; asm volatile("v_cvt_pk_bf16_f32 %0, %1, %2" : "=v"(r) : "v"(lo), "v"(hi)); return r; }

template <class Epi, class Sched, bool ALIGN_EPI, bool GATHER = false, bool F8 = false>
__device__ __forceinline__ void gemm_phase(LAS unsigned char* lds, const int tid, const int lda, const int ldb, const int K, const Sched& S, const Epi& E) {
    const int wid = __builtin_amdgcn_readfirstlane(tid >> 6), lane = tid & 63, wr = wid >> 2, wc = wid & 3, fr = lane & 15, fq = lane >> 4;
    const int nt = K / BK;
    unsigned voffA[2], voffB[2];
#pragma unroll
    for (int i = 0; i < 2; ++i) { int R, C; stage_rc(tid * 16 + i * 8192, R, C); const int Rb = (R & ~31) + perm32(R & 31);
        voffA[i] = (unsigned)(R * lda + C) * 2u; voffB[i] = (unsigned)(Rb * ldb + C) * 2u; }
    const size_t kstep = (size_t)(BK * 2);
    const size_t hstepA = GATHER ? (size_t)0 : (size_t)HALF * lda * 2, hstepB = (size_t)HALF * ldb * 2;
    unsigned cvo[2][2];
    const unsigned ldsw = (unsigned)wid * 1024u;
    const int aoff = lds_byte(wr * 64 + fr, fq * 8), boff = lds_byte(wc * 32 + fr, fq * 8);
#define PG8_SA(b, h) (((b) * 2 + (h)) * HTB)
#define PG8_SB(b, h) ((4 + (b) * 2 + (h)) * HTB)
#define PG8_STAGE(bufoff, gbase, voff) do { _Pragma("unroll") for (int _i = 0; _i < 2; ++_i) \
        __builtin_amdgcn_global_load_lds((const unsigned*)((const char*)(gbase) + (voff)[_i]), (LAS unsigned*)(lds + (bufoff) + ldsw + _i * 8192), 16, 0, 0); } while (0)
#define PG8_STAGE_A(bufoff, gbase, hh, vo) do { if constexpr (GATHER) { PG8_STAGE(bufoff, gbase, (vo)[hh]); } else { PG8_STAGE(bufoff, (gbase) + (hh) * hstepA, voffA); } } while (0)
#define PG8_GOFFS(u, vo) do { if constexpr (GATHER) { const int* _ix = S.idx(u); _Pragma("unroll") for (int _h = 0; _h < 2; ++_h) _Pragma("unroll") for (int _i = 0; _i < 2; ++_i) { int _gR, _gC; stage_rc(tid * 16 + _i * 8192, _gR, _gC); const int _r = (u).pm * BM + _h * HALF + _gR; \
        const int _tk = _ix[_r < (u).n ? _r : 0] >> 1; const int _tok = _r < (u).n ? _tk : 0; (vo)[_h][_i] = (unsigned)(_tok * lda + _gC) * 2u; } } } while (0)
#define PG8_LD8(p) __builtin_shufflevector(*(const LAS i32x4*)(p), *(const LAS i32x4*)((p) + 1024), 0, 1, 2, 3, 4, 5, 6, 7)
#define PG8_LDA(dst, b, h) do { if constexpr (F8) { _Pragma("unroll") for (int m = 0; m < 4; ++m) dst##8[m] = PG8_LD8(lds + PG8_SA(b, h) + aoff + m * 2048); } \
      else { _Pragma("unroll") for (int m = 0; m < 4; ++m) _Pragma("unroll") for (int k = 0; k < 2; ++k) dst[m][k] = *(const LAS bf16x8*)(lds + PG8_SA(b, h) + aoff + m * 2048 + k * 1024); } } while (0)
#define PG8_LDB(dst, b, h) do { if constexpr (F8) { _Pragma("unroll") for (int n = 0; n < 2; ++n) dst##8[n] = PG8_LD8(lds + PG8_SB(b, h) + boff + n * 2048); } \
      else { _Pragma("unroll") for (int n = 0; n < 2; ++n) _Pragma("unroll") for (int k = 0; k < 2; ++k) dst[n][k] = *(const LAS bf16x8*)(lds + PG8_SB(b, h) + boff + n * 2048 + k * 1024); } } while (0)
#define PG8_MMA(ai, bj, At, Bt) do { __builtin_amdgcn_s_setprio(1); if constexpr (F8) { _Pragma("unroll") for (int m = 0; m < 4; ++m) _Pragma("unroll") for (int n = 0; n < 2; ++n) \
        asm volatile("v_mfma_f32_16x16x128_f8f6f4 %0, %1, %2, %0" : "+v"(acc[ai][bj][m][n]) : "v"(Bt##8[n]), "v"(At##8[m])); } \
      else { _Pragma("unroll") for (int m = 0; m < 4; ++m) _Pragma("unroll") for (int n = 0; n < 2; ++n) _Pragma("unroll") for (int k = 0; k < 2; ++k) \
        acc[ai][bj][m][n] = __builtin_amdgcn_mfma_f32_16x16x32_bf16(Bt[n][k], At[m][k], acc[ai][bj][m][n], 0, 0, 0); } __builtin_amdgcn_s_setprio(0); } while (0)
#define PG8_WAIT_V(n) asm volatile("s_waitcnt vmcnt(" #n ")" ::: "memory")
#define PG8_WAIT_L(n) asm volatile("s_waitcnt lgkmcnt(" #n ")" ::: "memory")
#define PG8_BAR __builtin_amdgcn_s_barrier()
#define PG8_SCHED __builtin_amdgcn_sched_barrier(0)
    Unit cur, nxt; int ui = 0;
    if (!S.next(0, cur)) return;
    f32x4 acc[2][2][4][2];
#pragma unroll
    for (int a = 0; a < 2; ++a)
#pragma unroll
        for (int b = 0; b < 2; ++b)
#pragma unroll
            for (int m = 0; m < 4; ++m)
#pragma unroll
                for (int n = 0; n < 2; ++n) acc[a][b][m][n] = (f32x4){0.f, 0.f, 0.f, 0.f};
    bf16x8 At[4][2], B0[2][2], B1[2][2]; i32x8 At8[4], B08[2], B18[2];
    const char* cA = cur.A; const char* cB = cur.B;
    PG8_GOFFS(cur, cvo);
    PG8_STAGE(PG8_SB(0, 0), cB, voffB); PG8_STAGE(PG8_SB(0, 1), cB + hstepB, voffB); PG8_STAGE_A(PG8_SA(0, 0), cA, 0, cvo); PG8_STAGE_A(PG8_SA(0, 1), cA, 1, cvo);
    if (wr == 1) PG8_BAR;
    PG8_WAIT_V(2); PG8_BAR;
    PG8_STAGE(PG8_SB(1, 0), cB + kstep, voffB); PG8_STAGE_A(PG8_SA(1, 0), cA + kstep, 0, cvo); PG8_STAGE(PG8_SB(1, 1), cB + hstepB + kstep, voffB);
    PG8_WAIT_V(6); PG8_BAR;
    for (;;) {
        const bool has_next = S.next(ui + 1, nxt);
        const char* nA = has_next ? nxt.A : cA; const char* nB = has_next ? nxt.B : cB;
#pragma nounroll
        for (int t = 0; t < nt; t += 2) {
            const bool last = (t == nt - 2);
            if constexpr (GATHER) asm volatile("" : "+v"(cvo[0][0]), "+v"(cvo[0][1]), "+v"(cvo[1][0]), "+v"(cvo[1][1]));
            asm volatile("" : "+v"(voffA[0]), "+v"(voffA[1]), "+v"(voffB[0]), "+v"(voffB[1]));
            const char* a1 = cA + (size_t)(t + 1) * kstep;
            const char* a2 = last ? nA : cA + (size_t)(t + 2) * kstep; const char* b2 = last ? nB : cB + (size_t)(t + 2) * kstep;
            const char* a3 = a2 + kstep; const char* b3 = b2 + kstep;
            PG8_LDB(B0, 0, 0); PG8_LDB(B1, 0, 1); PG8_SCHED; PG8_LDA(At, 0, 0); PG8_STAGE_A(PG8_SA(1, 1), a1, 1, cvo);
            if constexpr (GATHER) { if (last && has_next) { PG8_GOFFS(nxt, cvo); } }
            PG8_WAIT_V(8); PG8_WAIT_L(0); PG8_BAR; PG8_MMA(0, 0, At, B0); PG8_MMA(0, 1, At, B1); PG8_BAR; PG8_SCHED;
            PG8_LDA(At, 0, 1); PG8_STAGE(PG8_SB(0, 0), b2, voffB); PG8_STAGE(PG8_SB(0, 1), b2 + hstepB, voffB); PG8_STAGE_A(PG8_SA(0, 0), a2, 0, cvo);
            PG8_WAIT_V(8); PG8_WAIT_L(0); PG8_BAR; PG8_MMA(1, 0, At, B0); PG8_MMA(1, 1, At, B1); PG8_BAR; PG8_SCHED;
            PG8_LDB(B0, 1, 0); PG8_LDB(B1, 1, 1); PG8_SCHED; PG8_LDA(At, 1, 0); PG8_STAGE_A(PG8_SA(0, 1), a2, 1, cvo);
            PG8_WAIT_V(8); PG8_WAIT_L(0); PG8_BAR; PG8_MMA(0, 0, At, B0); PG8_MMA(0, 1, At, B1); PG8_BAR; PG8_SCHED;
            PG8_LDA(At, 1, 1); PG8_STAGE(PG8_SB(1, 0), b3, voffB); PG8_STAGE(PG8_SB(1, 1), b3 + hstepB, voffB); PG8_STAGE_A(PG8_SA(1, 0), a3, 0, cvo);
            PG8_WAIT_V(8); PG8_WAIT_L(0); PG8_BAR; PG8_MMA(1, 0, At, B0); PG8_MMA(1, 1, At, B1); PG8_BAR; PG8_SCHED;
        }
        if constexpr (ALIGN_EPI) { if (wr == 0) PG8_BAR; }
        if constexpr (F8) asm volatile("s_nop 15\n\ts_nop 15" ::: "memory");
        if constexpr (!Epi::AFTER_DRAIN) { unsigned z_ = 0u; asm volatile("" : "+s"(z_)); const int l_ = (int)__builtin_amdgcn_mbcnt_hi(~0u, __builtin_amdgcn_mbcnt_lo(~0u, z_));
            E(acc, cur, wr, wc, l_ & 15, l_ >> 4); }
        if (!has_next) break;
#pragma unroll
        for (int a = 0; a < 2; ++a)
#pragma unroll
            for (int b = 0; b < 2; ++b)
#pragma unroll
                for (int m = 0; m < 4; ++m)
#pragma unroll
                    for (int n = 0; n < 2; ++n) acc[a][b][m][n] = (f32x4){0.f, 0.f, 0.f, 0.f};
        cur = nxt; cA = nA; cB = nB; ++ui;
        if constexpr (ALIGN_EPI) { if (wr == 1) PG8_BAR; }
    }
    PG8_WAIT_V(0);
    if constexpr (!ALIGN_EPI) { if (wr == 0) PG8_BAR; }
    PG8_BAR;
    if constexpr (F8 && Epi::AFTER_DRAIN) asm volatile("s_nop 15\n\ts_nop 15" ::: "memory");
    if constexpr (Epi::AFTER_DRAIN) { unsigned z_ = 0u; asm volatile("" : "+s"(z_)); const int l_ = (int)__builtin_amdgcn_mbcnt_hi(~0u, __builtin_amdgcn_mbcnt_lo(~0u, z_));
        E.fused(acc, cur, wr, wc, l_ & 15, l_ >> 4, lds, wid, l_); }
#undef PG8_SA
#undef PG8_SB
#undef PG8_STAGE
#undef PG8_STAGE_A
#undef PG8_GOFFS
#undef PG8_LDA
#undef PG8_LDB
#undef PG8_MMA
#undef PG8_LD8
#undef PG8_WAIT_V
#undef PG8_WAIT_L
#undef PG8_BAR
#undef PG8_SCHED
}

struct DenseOrder {
    const char* A; const char* B; int lda, ldb, nM, nN, nwg, G, c;
    __device__ __forceinline__ void init(const void* A_, const void* B_, int lda_, int ldb_, int M, int N, int G_, int c_) { A = (const char*)A_; B = (const char*)B_; lda = lda_; ldb = ldb_; nM = M / BM; nN = N / BM; nwg = nM * nN; G = G_; c = c_; }
    __device__ __forceinline__ bool next(int i, Unit& u) const {
        const long L = (long)i * G + c; if (L >= nwg) return false;
        int wgid = (int)L; { const int q = nwg / 8, r = nwg % 8, xcd = wgid % 8, off = wgid / 8; wgid = (xcd < r ? xcd * (q + 1) : r * (q + 1) + (xcd - r) * q) + off; }
        const int nig = 8 * nN, gid = wgid / nig, fm = gid * 8, gsz = (nM - fm) < 8 ? (nM - fm) : 8;
        u.pm = fm + ((wgid % nig) % gsz); u.pn = (wgid % nig) / gsz; u.z = 0; u.n = 0; u.base = 0;
        u.A = A + (size_t)u.pm * BM * lda * 2; u.B = B + (size_t)u.pn * BM * ldb * 2; return true;
    }
};
struct MaskOrder {
    const char* A; const char* B; int lda, ldb, nM, nN, nwg, G, c; unsigned mask;
    __device__ __forceinline__ void init(const void* A_, const void* B_, int lda_, int ldb_, int M, unsigned mask_, int G_, int c_) { A = (const char*)A_; B = (const char*)B_; lda = lda_; ldb = ldb_; nM = M / BM; mask = mask_; nN = __builtin_popcount(mask_); nwg = nM * nN; G = G_; c = c_; }
    __device__ __forceinline__ bool next(int i, Unit& u) const {
        const long L = (long)i * G + c; if (L >= nwg) return false;
        int wgid = (int)L; { const int q = nwg / 8, r = nwg % 8, xcd = wgid % 8, off = wgid / 8; wgid = (xcd < r ? xcd * (q + 1) : r * (q + 1) + (xcd - r) * q) + off; }
        const int nig = 8 * nN, gid = wgid / nig, fm = gid * 8, gsz = (nM - fm) < 8 ? (nM - fm) : 8;
        u.pm = fm + ((wgid % nig) % gsz); int k = (wgid % nig) / gsz, pn = 0;
        for (int b = 0; b < 32; ++b) if ((mask >> b) & 1u) { if (k == 0) { pn = b; break; } --k; }
        u.pn = pn; u.z = 0; u.n = 0; u.base = 0;
        u.A = A + (size_t)u.pm * BM * lda * 2; u.B = B + (size_t)u.pn * BM * ldb * 2; return true;
    }
};
struct MultiOrder {
    const char* A; const char* B; size_t a1, a2, a3, b1, b2, b3; int zs, zm, zs3, nM, nN, nz, lda, ldb, G, c;
    __device__ __forceinline__ bool next(int i, Unit& u) const {
        const long L = (long)i * G + c; const int per = nM * nN; if (L >= (long)per * nz) return false;
        const int z = (int)(L / per), r = (int)(L % per);
        u.pm = r / nN; u.pn = r % nN; u.z = z; u.n = 0; u.base = 0;
        u.A = A + (size_t)(z >> zs) * a1 + (size_t)(z & zm) * a2 + (size_t)(z >> zs3) * a3 + (size_t)u.pm * BM * lda * 2;
        u.B = B + (size_t)(z >> zs) * b1 + (size_t)(z & zm) * b2 + (size_t)(z >> zs3) * b3 + (size_t)u.pn * BM * ldb * 2; return true;
    }
};

__device__ __forceinline__ void rowscale4(const float* part, size_t rowb, int fq, int lane, float (&sc)[4]) {
    f32x4 a[4], b[4];
#pragma unroll
    for (int m = 0; m < 4; ++m) { const f32x4* p = (const f32x4*)(part + (rowb + 16 * m) * 32 + fq * 8); a[m] = p[0]; b[m] = p[1]; }
#pragma unroll
    for (int m = 0; m < 4; ++m) { float s = ((a[m].x + a[m].y) + (a[m].z + a[m].w)) + ((b[m].x + b[m].y) + (b[m].z + b[m].w));
        s = sum_x32(sum_x16(s, lane), lane); sc[m] = rsqrtf(s * (1.f / D) + EPS); }
}
template <int SC, bool INP8 = false, bool V8 = false> struct EpiStore {
    static constexpr bool AFTER_DRAIN = false;
    bf16_t* O; size_t o1, o2; int zs, zm, ldc; const float* rv; size_t rvz;
    float s8;
    __device__ __forceinline__ void operator()(const f32x4 (&acc)[2][2][4][2], const Unit& u, int wr, int wc, int fr, int fq) const {
        const int row0 = u.pm * BM + wr * 64 + fr, col0 = u.pn * BM + wc * 32 + 8 * fq;
        bf16_t* base = O + (size_t)(u.z >> zs) * o1 + (size_t)(u.z & zm) * o2;
#pragma unroll
        for (int ai = 0; ai < 2; ++ai) {
            float sc[4] = {1.f, 1.f, 1.f, 1.f};
            if (SC == 1) rowscale4(rv, (size_t)u.z * rvz + row0 + ai * HALF, fq, fr + 16 * fq, sc);
            if constexpr (INP8) { const float cs = (u.pn < 4 ? SC_A : ((u.pn >= 12 && u.pn < 16) ? SC_B : 1.f)) * (1.f / W8S);
#pragma unroll
                for (int m = 0; m < 4; ++m) sc[m] *= cs; }
            if (SC == 2) {
#pragma unroll
                for (int m = 0; m < 4; ++m) sc[m] = rv[(size_t)u.z * rvz + row0 + ai * HALF + m * 16]; }
#pragma unroll
            for (int m = 0; m < 4; ++m) { const int row = row0 + ai * HALF + m * 16;
                bf16_t* rowp = base + (size_t)row * ldc + col0;
                if constexpr (V8) { { unsigned char* rp8 = (unsigned char*)O + (size_t)(u.z >> zs) * o1 + (size_t)(u.z & zm) * o2 + (size_t)row * ldc + col0; const float s8m = sc[m] * s8;
#pragma unroll
                    for (int bj = 0; bj < 2; ++bj) { const f32x4 v0 = acc[ai][bj][m][0] * s8m, v1 = acc[ai][bj][m][1] * s8m;
                        u32x2 w8; w8.x = pk8(clamp8(v0[0]), clamp8(v0[1]), clamp8(v0[2]), clamp8(v0[3])); w8.y = pk8(clamp8(v1[0]), clamp8(v1[1]), clamp8(v1[2]), clamp8(v1[3]));
                        *(u32x2*)(rp8 + bj * HALF) = w8; }
                    continue; } }
#pragma unroll
                for (int bj = 0; bj < 2; ++bj) { const f32x4 v0 = acc[ai][bj][m][0] * sc[m], v1 = acc[ai][bj][m][1] * sc[m];
                    u32x4 w; w.x = cvt_pk_bf16(v0[0], v0[1]); w.y = cvt_pk_bf16(v0[2], v0[3]); w.z = cvt_pk_bf16(v1[0], v1[1]); w.w = cvt_pk_bf16(v1[2], v1[3]);
                    *(u32x4*)(rowp + bj * HALF) = w; } } }
    }
};
struct EpiResidualPart {
    static constexpr bool AFTER_DRAIN = false;
    bf16_t* X; float* part; size_t zrows;
    unsigned char* x8;
    float as;
    __device__ __forceinline__ void operator()(const f32x4 (&acc)[2][2][4][2], const Unit& u, int wr, int wc, int fr, int fq) const {
        const int row0 = u.pm * BM + wr * 64 + fr, col0 = u.pn * BM + wc * 32 + 8 * fq, lane = fr + 16 * fq;
#pragma unroll
        for (int ai = 0; ai < 2; ++ai) {
            u32x4 old[4][2];
#pragma unroll
            for (int m = 0; m < 4; ++m)
#pragma unroll
                for (int bj = 0; bj < 2; ++bj) old[m][bj] = *(const u32x4*)(X + ((size_t)u.z * zrows + row0 + ai * HALF + m * 16) * D + col0 + bj * HALF);
#pragma unroll
            for (int m = 0; m < 4; ++m) { const size_t row = (size_t)u.z * zrows + row0 + ai * HALF + m * 16;
                bf16_t* rowp = X + row * D + col0; float ss = 0.f;
#pragma unroll
                for (int bj = 0; bj < 2; ++bj) { u32x4 w;
#pragma unroll
                    for (int q = 0; q < 4; ++q) { const float lo = __uint_as_float(old[m][bj][q] << 16) + acc[ai][bj][m][q >> 1][(q & 1) * 2] * as, hi = __uint_as_float(old[m][bj][q] & 0xffff0000u) + acc[ai][bj][m][q >> 1][(q & 1) * 2 + 1] * as;
                        w[q] = cvt_pk_bf16(lo, hi); const float a = __uint_as_float(w[q] << 16), b = __uint_as_float(w[q] & 0xffff0000u); ss += a * a + b * b; }
                    *(u32x4*)(rowp + bj * HALF) = w;
                    if (x8) { u32x2 e;
#pragma unroll
                        for (int h2 = 0; h2 < 2; ++h2) e[h2] = pk8(clamp8(__uint_as_float(w[2 * h2] << 16)), clamp8(__uint_as_float(w[2 * h2] & 0xffff0000u)), clamp8(__uint_as_float(w[2 * h2 + 1] << 16)), clamp8(__uint_as_float(w[2 * h2 + 1] & 0xffff0000u)));
                        *(u32x2*)(x8 + row * D + col0 + bj * HALF) = e; } }
                ss = sum_x32(sum_x16(ss, lane), lane);
                if (fq == 0) part[row * 32 + u.pn * 4 + wc] = ss; } }
    }
};
struct EpiSoftmaxP {
    static constexpr bool AFTER_DRAIN = true;
    bf16_t* P; const float* part; int f8; float as;
    __device__ __forceinline__ void fused(f32x4 (&acc)[2][2][4][2], const Unit& u, int wr, int wc, int fr, int fq, LAS unsigned char* lds, int wid, int lane) const {
        LAS float* MX = (LAS float*)lds; LAS float* SM = (LAS float*)(lds + 4096);
        const int row0 = u.pm * BM + wr * 64 + fr, col0 = u.pn * BM + wc * 32 + 8 * fq;
#pragma unroll
        for (int ai = 0; ai < 2; ++ai) {
            float scv[4]; rowscale4(part, (size_t)u.z * SEQ + row0 + ai * HALF, fq, lane, scv);
#pragma unroll
            for (int m = 0; m < 4; ++m) { const float sc = scv[m] * as; float mx = -3.0e38f;
#pragma unroll
                for (int bj = 0; bj < 2; ++bj)
#pragma unroll
                    for (int n = 0; n < 2; ++n) { acc[ai][bj][m][n] = acc[ai][bj][m][n] * sc; const f32x4 v = acc[ai][bj][m][n]; mx = fmaxf(mx, fmaxf(fmaxf(v[0], v[1]), fmaxf(v[2], v[3]))); }
                mx = max_x32(max_x16(mx, lane), lane);
                if (fq == 0) MX[(ai * HALF + wr * 64 + m * 16 + fr) * 4 + wc] = mx; } }
        asm volatile("s_waitcnt lgkmcnt(0)" ::: "memory"); __builtin_amdgcn_s_barrier(); asm volatile("" ::: "memory");
#pragma unroll
        for (int ai = 0; ai < 2; ++ai)
#pragma unroll
            for (int m = 0; m < 4; ++m) { const int R = ai * HALF + wr * 64 + m * 16 + fr; const f32x4 mv = *(const LAS f32x4*)(MX + R * 4);
                const float gm = fmaxf(fmaxf(mv[0], mv[1]), fmaxf(mv[2], mv[3])); float s = 0.f;
#pragma unroll
                for (int bj = 0; bj < 2; ++bj)
#pragma unroll
                    for (int n = 0; n < 2; ++n) { f32x4 v = acc[ai][bj][m][n];
#pragma unroll
                        for (int q = 0; q < 4; ++q) { v[q] = __builtin_amdgcn_exp2f(v[q] - gm); s += v[q]; }
                        acc[ai][bj][m][n] = v; }
                s = sum_x32(sum_x16(s, lane), lane);
                if (fq == 0) SM[R * 4 + wc] = s; }
        asm volatile("s_waitcnt lgkmcnt(0)" ::: "memory"); __builtin_amdgcn_s_barrier(); asm volatile("" ::: "memory");
#pragma unroll
        for (int ai = 0; ai < 2; ++ai)
#pragma unroll
            for (int m = 0; m < 4; ++m) { const int R = ai * HALF + wr * 64 + m * 16 + fr; const f32x4 sv = *(const LAS f32x4*)(SM + R * 4);
                const float inv = 1.f / ((sv[0] + sv[1]) + (sv[2] + sv[3]));
                bf16_t* rowp = P + ((size_t)u.z * SEQ + row0 + ai * HALF + m * 16) * 1024 + col0;
                if (f8) { unsigned char* rowp8 = (unsigned char*)P + ((size_t)u.z * SEQ + row0 + ai * HALF + m * 16) * 1024 + col0; const float i8 = inv * P8S;
#pragma unroll
                    for (int bj = 0; bj < 2; ++bj) { const f32x4 v0 = acc[ai][bj][m][0] * i8, v1 = acc[ai][bj][m][1] * i8;
                        u32x2 w8; w8.x = pk8(v0[0], v0[1], v0[2], v0[3]); w8.y = pk8(v1[0], v1[1], v1[2], v1[3]);
                        *(u32x2*)(rowp8 + bj * HALF) = w8; } }
                else {
#pragma unroll
                for (int bj = 0; bj < 2; ++bj) { const f32x4 v0 = acc[ai][bj][m][0] * inv, v1 = acc[ai][bj][m][1] * inv;
                    u32x4 w; w.x = cvt_pk_bf16(v0[0], v0[1]); w.y = cvt_pk_bf16(v0[2], v0[3]); w.z = cvt_pk_bf16(v1[0], v1[1]); w.w = cvt_pk_bf16(v1[2], v1[3]);
                    *(u32x4*)(rowp + bj * HALF) = w; } } }
        asm volatile("s_waitcnt lgkmcnt(0)" ::: "memory"); __builtin_amdgcn_s_barrier(); asm volatile("" ::: "memory");
    }
};
template <int NTN, bool UP> struct MoeOrder {
    int cv;
    const int* ltok; const char* A; const char* B; size_t bstride; int lda, ldb, G, c;
    __device__ __forceinline__ const int* idx(const Unit& u) const { return ltok + (size_t)u.z * T; }
    __device__ __forceinline__ bool next(int i, Unit& u) const {
        const long L = (long)i * G + c; long accu = 0; int base = 0;
        for (int e = 0; e < NE; ++e) { const int n = __builtin_amdgcn_readlane(cv, e); const int nt = ((n + 255) >> 8) * NTN;
            if (L < accu + nt) { const int r = (int)(L - accu); u.pm = r / NTN; u.pn = r % NTN; u.z = e; u.n = n; u.base = base;
                u.A = UP ? A : A + (size_t)(base + u.pm * BM) * lda * 2; u.B = B + (size_t)e * bstride + (size_t)u.pn * BM * ldb * 2; return true; }
            accu += nt; base += (n + 255) & ~255; }
        return false;
    }
};
template <bool F8 = false> struct EpiMoeUpF {
    static constexpr bool AFTER_DRAIN = false;
    bf16_t* hid; const float* lw; const float* lr;
    __device__ __forceinline__ void operator()(const f32x4 (&acc)[2][2][4][2], const Unit& u, int wr, int wc, int fr, int fq) const {
        const int r0 = u.pm * BM + wr * 64 + fr, f0 = u.pn * 128 + wc * 32 + 8 * fq;
        float rsv[2][4], wv[2][4];
#pragma unroll
        for (int ai = 0; ai < 2; ++ai)
#pragma unroll
            for (int m = 0; m < 4; ++m) { const int r = r0 + ai * HALF + m * 16; rsv[ai][m] = lr[(size_t)u.z * T + r]; wv[ai][m] = lw[(size_t)u.z * T + r]; }
#pragma unroll
        for (int ai = 0; ai < 2; ++ai)
#pragma unroll
            for (int m = 0; m < 4; ++m) { const int r = r0 + ai * HALF + m * 16;
                if (r < u.n) { const float rs = rsv[ai][m] * (F8 ? 1.f / W8S : 1.f), w = wv[ai][m] * (F8 ? H8S : 1.f); float hv[8];
#pragma unroll
                    for (int q = 0; q < 8; ++q) { const float a = acc[ai][0][m][q >> 2][q & 3] * rs, b = acc[ai][1][m][q >> 2][q & 3] * rs;
                        hv[q] = a * __builtin_amdgcn_rcpf(1.f + __builtin_amdgcn_exp2f(-a * LOG2E)) * b * w; }
                    if constexpr (F8) { u32x2 o8; o8.x = pk8(clamp8(hv[0]), clamp8(hv[1]), clamp8(hv[2]), clamp8(hv[3])); o8.y = pk8(clamp8(hv[4]), clamp8(hv[5]), clamp8(hv[6]), clamp8(hv[7]));
                        *(u32x2*)((unsigned char*)hid + (size_t)(u.base + r) * DE + f0) = o8; }
                    else { u32x4 o; o.x = cvt_pk_bf16(hv[0], hv[1]); o.y = cvt_pk_bf16(hv[2], hv[3]); o.z = cvt_pk_bf16(hv[4], hv[5]); o.w = cvt_pk_bf16(hv[6], hv[7]);
                        *(u32x4*)(hid + (size_t)(u.base + r) * DE + f0) = o; } } }
    }
};
template <bool F8 = false> struct EpiMoeDownF {
    static constexpr bool AFTER_DRAIN = false;
    bf16_t* Y; const int* ltok;
    __device__ __forceinline__ void operator()(const f32x4 (&acc)[2][2][4][2], const Unit& u, int wr, int wc, int fr, int fq) const {
        const int r0 = u.pm * BM + wr * 64 + fr, col0 = u.pn * BM + wc * 32 + 8 * fq;
        int ev[2][4];
#pragma unroll
        for (int ai = 0; ai < 2; ++ai)
#pragma unroll
            for (int m = 0; m < 4; ++m) ev[ai][m] = ltok[(size_t)u.z * T + r0 + ai * HALF + m * 16];
#pragma unroll
        for (int ai = 0; ai < 2; ++ai)
#pragma unroll
            for (int m = 0; m < 4; ++m) { const int r = r0 + ai * HALF + m * 16;
                if (r < u.n) { const int e = ev[ai][m]; bf16_t* rowp = Y + ((size_t)(e & 1) * T + (e >> 1)) * D + col0;
#pragma unroll
                    for (int bj = 0; bj < 2; ++bj) { constexpr float ds = F8 ? Y8S / (W8S * H8S) : 1.f; const f32x4 v0 = acc[ai][bj][m][0] * ds, v1 = acc[ai][bj][m][1] * ds;
                        if constexpr (F8) { u32x2 w8; w8.x = pk8(clamp8(v0[0]), clamp8(v0[1]), clamp8(v0[2]), clamp8(v0[3])); w8.y = pk8(clamp8(v1[0]), clamp8(v1[1]), clamp8(v1[2]), clamp8(v1[3]));
                            *(u32x2*)((unsigned char*)Y + ((size_t)(e & 1) * T + (e >> 1)) * D + col0 + bj * HALF) = w8; }
                        else { u32x4 w; w.x = cvt_pk_bf16(v0[0], v0[1]); w.y = cvt_pk_bf16(v0[2], v0[3]); w.z = cvt_pk_bf16(v1[0], v1[1]); w.w = cvt_pk_bf16(v1[2], v1[3]);
                            *(u32x4*)(rowp + bj * HALF) = w; } } } }
    }
};
}

constexpr int NPRO = 3, NPL = 9, NPH = NPRO + NL * NPL;
#ifndef Q_X1
#define Q_X1 8
#endif
#ifndef Q_UP
#define Q_UP 8
#endif

__global__ void __launch_bounds__(NTHREADS, 2) mk_fwd(Args args) {
    extern __shared__ __attribute__((aligned(16))) unsigned char lds_raw[];
    Ctx C;
    C.ka = (const __attribute__((address_space(4))) unsigned char*)__builtin_amdgcn_kernarg_segment_ptr();
    C.out = args.out; C.ws = (GAS unsigned char*)args.ws;
    C.lds = (LAS unsigned char*)lds_raw;
    C.tid = threadIdx.x; C.lane = C.tid & 63; C.wave = __builtin_amdgcn_readfirstlane(C.tid >> 6);
    C.gw = blockIdx.x * NWAVES + C.wave; C.ngw = gridDim.x * NWAVES;
    volatile LAS unsigned* MISC = (volatile LAS unsigned*)(C.lds + LDS_MISC);
    if (C.tid < 32) MISC[C.tid] = 0u;
    __syncthreads();
    XcdBarrier bar = xcd_barrier_post(WSP(unsigned, WS_CTL) + CW_BAR, MISC + 8);
    const int lo = args.ph_lo, hi = args.ph_hi;
    const int G = (int)gridDim.x, cb = (int)blockIdx.x;
#define XCD_C(tot) ((G >= (tot)) ? ((cb < (tot)) ? ((cb & 7) * ((tot) >> 3) + (cb >> 3)) : (tot)) : cb)
#define XCD_G(tot) ((G >= (tot)) ? (1 << 20) : G)
    int p = 0;
#define PH_BEGIN if (p >= lo && p < hi) { { unsigned z0_ = 0u; asm volatile("" : "+s"(C.ws), "+s"(z0_), "+s"(C.ka));     \
        C.lane = (int)__builtin_amdgcn_mbcnt_hi(~0u, __builtin_amdgcn_mbcnt_lo(~0u, z0_)); C.tid = C.wave * 64 + C.lane; }
#define PH_END   if (p + 1 < hi) xcd_barrier(bar, C.tid); else __syncthreads(); } ++p;

    PH_BEGIN phase_prologue(C); PH_END
    PH_BEGIN
        pg8::MultiOrder S{(const char*)WSP(unsigned char, WS_MEMB), (const char*)WSP(unsigned char, WS_WKV), 0, 0, 0, (size_t)4096 * D, 0, 0, 0, 0, 0, 2, 16, NL, D / 2, D / 2, XCD_G(128), XCD_C(128)};
        pg8::EpiStore<2, false, true> E{WSP(bf16_t, WS_KVB), (size_t)MT * 4096, 0, 0, 0, 4096, WSP(float, WS_RMEM), 0, 1.f / W8S};
        pg8::gemm_phase<pg8::EpiStore<2, false, true>, pg8::MultiOrder, true, false, true>(C.lds, C.tid, D / 2, D / 2, D / 2, S, E);
    PH_END
    PH_BEGIN
        { pg8::MultiOrder S{(const char*)WSP(unsigned char, WS_KVB), (const char*)WSP(unsigned char, WS_WQS), (size_t)MEM * 4096, 512, 0, 0, 512, (size_t)D * D, 2, 3, 3, 1, 8, NL * NB * 4, 2048, D / 2, XCD_G(256), XCD_C(256)};
          pg8::EpiStore<0, false, true> E{WSP(bf16_t, WS_WQK), (size_t)1024 * D, (size_t)256 * D, 2, 3, D, nullptr, 0, V8S / Q8S};
          pg8::gemm_phase<pg8::EpiStore<0, false, true>, pg8::MultiOrder, false, false, true>(C.lds, C.tid, 2048, D / 2, 256, S, E); }
        { pg8::MultiOrder S{(const char*)WSP(unsigned char, WS_WXO), (const char*)(WSP(unsigned char, WS_KVB) + 2048), 0, 512, (size_t)D * D, (size_t)MEM * 4096, 512, 0, 2, 3, 3, 8, 1, NL * NB * 4, D / 2, 2048, XCD_G(256), XCD_C(256)};
          pg8::EpiStore<0, false, true> E{WSP(bf16_t, WS_VOT), (size_t)D * 1024, 256, 2, 3, 1024, nullptr, 0, V8S / W8S};
          pg8::gemm_phase<pg8::EpiStore<0, false, true>, pg8::MultiOrder, false, false, true>(C.lds, C.tid, D / 2, 2048, 256, S, E); }
    PH_END
    for (int l = 0; l < NL; ++l) {
        PH_BEGIN { { pg8::MaskOrder S; S.init(WSP(bf16_t, WS_XB), WSP(bf16_t, WS_WIN) + (size_t)l * INW * D, D, D, T, l >= L8 ? 0u : 0xFFFFFFu, G, cb);
                     pg8::EpiStore<1> E{WSP(bf16_t, WS_PROJ), 0, 0, 0, 0, INW, WSP(float, WS_PART), 0, 1.f};
                     pg8::gemm_phase<pg8::EpiStore<1>, pg8::MaskOrder, true>(C.lds, C.tid, D, D, D, S, E); }
                   { pg8::MaskOrder S; S.init(WSP(unsigned char, WS_X8), WSP(bf16_t, WS_WIN) + (size_t)l * INW * D, D / 2, D / 2, T, l >= L8 ? 0xFFFFFFu : 0u, G, cb);
                     pg8::EpiStore<1, true> E{WSP(bf16_t, WS_PROJ), 0, 0, 0, 0, INW, WSP(float, WS_PART), 0, 1.f};
                     pg8::gemm_phase<pg8::EpiStore<1, true>, pg8::MaskOrder, true, false, true>(C.lds, C.tid, D / 2, D / 2, D / 2, S, E); } } PH_END
        PH_BEGIN phase_attn(C, l); PH_END
        PH_BEGIN { pg8::DenseOrder S; pg8::EpiResidualPart E{WSP(bf16_t, WS_XB), WSP(float, WS_PART), 0, l >= L8X ? WSP(unsigned char, WS_X8) : nullptr, l >= L8B ? 1.f / W8S : 1.f};
                   if (l >= L8B) { S.init(WSP(bf16_t, WS_MIX), WSP(bf16_t, WS_WOUT) + (size_t)l * D * D, D / 2, D / 2, T, D, G, cb);
                       pg8::gemm_phase<pg8::EpiResidualPart, pg8::DenseOrder, false, false, true>(C.lds, C.tid, D / 2, D / 2, D / 2, S, E); }
                   else { S.init(WSP(bf16_t, WS_MIX), WSP(bf16_t, WS_WOUT) + (size_t)l * D * D, D, D, T, D, G, cb);
                       pg8::gemm_phase<pg8::EpiResidualPart, pg8::DenseOrder, false>(C.lds, C.tid, D, D, D, S, E); } } PH_END
        PH_BEGIN { if (l + 1 < NL && G >= 256 && cb >= 128) convert_pull(C, l + 1, Q_X1, nullptr);
                   pg8::MultiOrder S{(const char*)WSP(bf16_t, WS_XB), (const char*)(WSP(bf16_t, WS_WQK) + (size_t)l * NB * 1024 * D), (size_t)SEQ * D * 2, 0, 0, (size_t)1024 * D * 2, 0, 0, 0, 0, 0, 16, 4, NB, D, D, XCD_G(128), XCD_C(128)};
                   pg8::EpiSoftmaxP E{WSP(bf16_t, WS_P), WSP(float, WS_PART), l >= L8X ? 1 : 0, l >= L8X ? 1.f / V8S : 1.f};
                   if (l >= L8X) { S.A = (const char*)WSP(unsigned char, WS_X8); S.a1 = (size_t)SEQ * D; S.lda = D / 2; S.ldb = D / 2; S.B = (const char*)WSP(unsigned char, WS_WQK) + (size_t)l * NB * 1024 * D; S.b1 = (size_t)1024 * D;
                       pg8::gemm_phase<pg8::EpiSoftmaxP, pg8::MultiOrder, false, false, true>(C.lds, C.tid, D / 2, D / 2, D / 2, S, E); }
                   else pg8::gemm_phase<pg8::EpiSoftmaxP, pg8::MultiOrder, false>(C.lds, C.tid, D, D, D, S, E); } PH_END
        PH_BEGIN { pg8::MultiOrder S{(const char*)WSP(bf16_t, WS_P), (const char*)(WSP(bf16_t, WS_VOT) + (size_t)l * NB * D * 1024), (size_t)SEQ * 1024 * 2, 0, 0, (size_t)D * 1024 * 2, 0, 0, 0, 0, 0, 16, 8, NB, 1024, 1024, XCD_G(256), XCD_C(256)};
                   pg8::EpiResidualPart E{WSP(bf16_t, WS_XB), WSP(float, WS_PART), (size_t)SEQ, l >= L8M ? WSP(unsigned char, WS_X8) : nullptr, l >= L8X ? 1.f / (P8S * V8S) : 1.f};
                   if (l >= L8X) { S.a1 = (size_t)SEQ * 1024; S.lda = 512; S.ldb = 512; S.B = (const char*)WSP(unsigned char, WS_VOT) + (size_t)l * NB * D * 1024; S.b1 = (size_t)D * 1024;
                       pg8::gemm_phase<pg8::EpiResidualPart, pg8::MultiOrder, false, false, true>(C.lds, C.tid, 512, 512, 512, S, E); }
                   else pg8::gemm_phase<pg8::EpiResidualPart, pg8::MultiOrder, false>(C.lds, C.tid, 1024, 1024, 1024, S, E); } PH_END
        PH_BEGIN phase_router(C, l); PH_END
        PH_BEGIN { pg8::MoeOrder<2, true> S{(int)(WSP(unsigned, WS_CTL) + CW_CNT + l * NE * CNT_STRIDE)[(C.lane & 31) * CNT_STRIDE], WSP(int, WS_LTOK), (const char*)WSP(bf16_t, WS_XB), (const char*)(WSP(bf16_t, WS_W13) + (size_t)l * NE * 512 * D), (size_t)512 * D * 2, D, D, G, cb};
                   { pg8::Unit u0; if (l + 1 < NL && !S.next(0, u0)) convert_pull(C, l + 1, Q_UP, nullptr); }
                   if (l >= L8M) { S.A = (const char*)WSP(unsigned char, WS_X8); S.bstride = (size_t)512 * D; S.lda = D / 2; S.ldb = D / 2;
                       pg8::EpiMoeUpF<true> E{WSP(bf16_t, WS_HID), WSP(float, WS_LW), WSP(float, WS_LR)};
                       pg8::gemm_phase<pg8::EpiMoeUpF<true>, pg8::MoeOrder<2, true>, true, true, true>(C.lds, C.tid, D / 2, D / 2, D / 2, S, E); }
                   else { pg8::EpiMoeUpF<> E{WSP(bf16_t, WS_HID), WSP(float, WS_LW), WSP(float, WS_LR)};
                       pg8::gemm_phase<pg8::EpiMoeUpF<>, pg8::MoeOrder<2, true>, true, true>(C.lds, C.tid, D, D, D, S, E); } } PH_END
        PH_BEGIN { pg8::MoeOrder<8, false> S{(int)(WSP(unsigned, WS_CTL) + CW_CNT + l * NE * CNT_STRIDE)[(C.lane & 31) * CNT_STRIDE], WSP(int, WS_LTOK), (const char*)WSP(bf16_t, WS_HID), (const char*)(WSP(bf16_t, WS_W2) + (size_t)l * NE * D * DE), (size_t)D * DE * 2, DE, DE, G, cb};
                   if (l >= L8M) { S.bstride = (size_t)D * DE; S.lda = DE / 2; S.ldb = DE / 2;
                       pg8::EpiMoeDownF<true> E{WSP(bf16_t, WS_Y), WSP(int, WS_LTOK)};
                       pg8::gemm_phase<pg8::EpiMoeDownF<true>, pg8::MoeOrder<8, false>, true, false, true>(C.lds, C.tid, DE / 2, DE / 2, DE / 2, S, E); }
                   else { pg8::EpiMoeDownF<> E{WSP(bf16_t, WS_Y), WSP(int, WS_LTOK)};
                       pg8::gemm_phase<pg8::EpiMoeDownF<>, pg8::MoeOrder<8, false>, true, false>(C.lds, C.tid, DE, DE, DE, S, E); } } PH_END
        PH_BEGIN phase_combine(C, l); if (l + 1 < NL) convert_pull(C, l + 1, LAYER_ITEMS, nullptr); PH_END
    }
}

extern "C" void kernel_launch(void* const* d_in, const int* in_sizes, int n_in, void* d_out, int out_size, void* d_ws, size_t ws_size, hipStream_t stream) {
    static int grid = 0;
    if (grid == 0) {
        if (n_in != 23 || in_sizes[0] != T * D || out_size != T * D || ws_size < WS_END) {
            fprintf(stderr, "kernel_launch: unexpected problem (n_in %d, in0 %d, out %d, ws %zu < %zu); nothing launched\n", n_in, n_in > 0 ? in_sizes[0] : -1, out_size, ws_size, (size_t)WS_END);
            grid = -1; return; }
        int dev = 0, cus = 0, per_cu = 0;
        if (hipGetDevice(&dev) != hipSuccess || hipDeviceGetAttribute(&cus, hipDeviceAttributeMultiprocessorCount, dev) != hipSuccess) { grid = -1; return; }
        if (hipFuncSetAttribute((const void*)mk_fwd, hipFuncAttributeMaxDynamicSharedMemorySize, LDS_BYTES) != hipSuccess) { fprintf(stderr, "kernel_launch: hipFuncSetAttribute failed\n"); grid = -1; return; }
        if (hipOccupancyMaxActiveBlocksPerMultiprocessor(&per_cu, (const void*)mk_fwd, NTHREADS, LDS_BYTES) != hipSuccess || per_cu < 1) {
            fprintf(stderr, "kernel_launch: occupancy query reports %d workgroups per CU\n", per_cu); (void)hipGetLastError(); grid = -1; return; }
        grid = cus;
    }
    if (grid < 0) return;
    if (hipMemsetAsync((char*)d_ws + WS_CTL, 0, CTL_BYTES, stream) != hipSuccess) return;
    Args a{};
    for (int i = 0; i < 23; ++i) a.in[i] = (const float*)d_in[i];
    a.out = (float*)d_out; a.ws = (unsigned char*)d_ws;
#if MK_MULTI
    for (int p = 0; p < NPH; ++p) { a.ph_lo = p; a.ph_hi = p + 1; hipLaunchKernelGGL(mk_fwd, dim3(grid), dim3(NTHREADS), LDS_BYTES, stream, a); }
#else
    a.ph_lo = 0; a.ph_hi = NPH;
    hipLaunchKernelGGL(mk_fwd, dim3(grid), dim3(NTHREADS), LDS_BYTES, stream, a);
#endif
    const hipError_t le = hipPeekAtLastError();
    if (le != hipSuccess) fprintf(stderr, "kernel_launch: launch failed: %s\n", hipGetErrorName(le));
}
```

```cpp
#include <hip/hip_runtime.h>
#include <cstdio>
#include <cstdint>

#ifndef MK_MULTI
#define MK_MULTI 0
#endif

typedef unsigned short bf16_t;
typedef short bf16x8 __attribute__((ext_vector_type(8)));
typedef int i32x4 __attribute__((ext_vector_type(4)));
typedef int i32x8 __attribute__((ext_vector_type(8)));
typedef float f32x16 __attribute__((ext_vector_type(16)));
typedef float f32x4 __attribute__((ext_vector_type(4)));
typedef unsigned u32x4 __attribute__((ext_vector_type(4)));
typedef unsigned u32x2 __attribute__((ext_vector_type(2)));
#define LAS __attribute__((address_space(3)))
#define GAS __attribute__((address_space(1)))
#define DI __device__ __forceinline__

constexpr int T = 8192, D = 2048, SEQ = 4096, NB = 2, NL = 4, INW = 6144;
constexpr int MEM = 256, MT = NB * MEM, NE = 32, DE = 256;
constexpr float EPS = 1e-6f;
constexpr float LOG2E = 1.4426950408889634f;
constexpr float SC_A = 0.08838834764831845f * LOG2E;
constexpr float SC_B = 0.125f * LOG2E;
constexpr float SC_X = 0.04419417382415922f * LOG2E;
constexpr int TABB_N = 640, TABB_OFF = 511;
constexpr int TABA_N = 320, TABA_OFF = 256;

constexpr size_t MiB = 1u << 20;
constexpr size_t WS_CTL = 0, CTL_BYTES = 1 * MiB;
constexpr int CW_BAR = 4096;
constexpr int CW_CNT = 16384, CNT_STRIDE = 16;
constexpr int CW_QH = 8192;
constexpr int CW_DONE = 8448;
constexpr size_t WS_TABB = 1 * MiB, WS_TABA = WS_TABB + 32768, WS_LAM = WS_TABB + 131072, WS_RMEM = WS_TABB + 135168;
static_assert(8 * TABB_N * 4 <= 32768 && NL * 8 * TABA_N * 4 <= 131072 - 32768, "bias tables fit their slots");
constexpr size_t WS_PART = 2 * MiB;
constexpr size_t WS_WRT = 3 * MiB;
constexpr size_t WS_LTOK = 5 * MiB, WS_LW = 6 * MiB, WS_LR = 7 * MiB;
constexpr size_t WS_XB = 16 * MiB, WS_MEMB = 48 * MiB, WS_KVB = 50 * MiB, WS_WQK = 66 * MiB, WS_VOT = 98 * MiB;
constexpr size_t WS_PROJ = 130 * MiB, WS_MIX = 226 * MiB, WS_P = 258 * MiB, WS_HID = 274 * MiB, WS_Y = 286 * MiB, WS_SCR = 350 * MiB;
constexpr size_t WS_WIN = 544 * MiB, WS_WOUT = 640 * MiB, WS_WQS = 672 * MiB, WS_WKV = 704 * MiB, WS_WXO = 768 * MiB, WS_W13 = 800 * MiB, WS_W2 = 1056 * MiB;
constexpr size_t WS_X8 = 1184 * MiB, WS_END = 1200 * MiB;
#ifndef F8_FROM
#define F8_FROM 1
#endif
#ifndef F8M_FROM
#define F8M_FROM 0
#endif
constexpr int L8M = F8M_FROM;
constexpr int L8 = F8_FROM;
constexpr float H8S = 16.f;
constexpr float Y8S = 16.f;
#ifndef F8B_FROM
#define F8B_FROM 2
#endif
constexpr int L8B = F8B_FROM;
#ifndef F8X_FROM
#define F8X_FROM 0
#endif
constexpr int L8X = F8X_FROM; static_assert(F8X_FROM == 0, "the prologue builds only the e4m3 Wqk / VoT");
constexpr float Q8S = 512.f;
constexpr float P8S = 256.f, V8S = 16.f;
constexpr int HID_ROWS = 24576;

constexpr int NWAVES = 8, NTHREADS = 512;
constexpr int LDS_BYTES = 147456;
constexpr int LDS_MISC = 139264;

DI float bf2f(bf16_t v) { return __uint_as_float((unsigned)v << 16); }
DI unsigned f2bf(float f) { unsigned u = __float_as_uint(f); return (u + 0x7fffu + ((u >> 16) & 1u)) >> 16; }
DI unsigned pk2(float lo, float hi) { return f2bf(lo) | (f2bf(hi) << 16); }
DI float bpx(float v, int lane, int m) { return __int_as_float(__builtin_amdgcn_ds_bpermute((lane ^ m) << 2, __float_as_int(v))); }
DI float sum_x16(float v, int lane) { return v + bpx(v, lane, 16); }
DI float max_x16(float v, int lane) { return fmaxf(v, bpx(v, lane, 16)); }
DI float sum_x32(float v, int lane) { return v + bpx(v, lane, 32); }
DI float max_x32(float v, int lane) { return fmaxf(v, bpx(v, lane, 32)); }
DI float wave_sum(float v, int lane) {
#pragma unroll
    for (int o = 1; o < 64; o <<= 1) v += bpx(v, lane, o);
    return v; }
DI float wave_max(float v, int lane) {
#pragma unroll
    for (int o = 1; o < 64; o <<= 1) v = fmaxf(v, bpx(v, lane, o));
    return v; }
DI float lane_get(float v, int src) { return __int_as_float(__builtin_amdgcn_ds_bpermute(src << 2, __float_as_int(v))); }
DI int crow(int r, int hi) { return (r & 3) + 8 * (r >> 2) + 4 * hi; }
#define MFMA32(a, b, c) __builtin_amdgcn_mfma_f32_32x32x16_bf16((a), (b), (c), 0, 0, 0)
#define LDS_WAIT() asm volatile("s_waitcnt lgkmcnt(0)" ::: "memory")
#define AT_BAR() asm volatile("s_waitcnt vmcnt(0) lgkmcnt(0)\n\ts_barrier" ::: "memory")

#define XB_TMO      128
#define XB_XCNT(j)  (256  + 64 * (j))
#define XB_XSUB(j)  (1280 + 64 * (j))
#define XB_XGEN(j)  (2304 + 64 * (j))
#define XB_TOP      3328
#define XB_TOPGEN   3392
#define XCD_BAR_WORDS 3456
#define XB_SPIN_CAP (1u << 18)
__device__ __forceinline__ unsigned xb_ld(unsigned* p)              { return __hip_atomic_load(p, __ATOMIC_RELAXED, __HIP_MEMORY_SCOPE_AGENT); }
__device__ __forceinline__ unsigned xb_add(unsigned* p, unsigned v) { return __hip_atomic_fetch_add(p, v, __ATOMIC_RELAXED, __HIP_MEMORY_SCOPE_AGENT); }
__device__ __forceinline__ unsigned xb_xcc_id() { return (unsigned)__builtin_amdgcn_s_getreg((3 << 11) | 20) & 0xFu; }
#define XB_SPIN(cond, bar) do { unsigned _sp = 0; while (cond) { __builtin_amdgcn_s_sleep(1); \
    if ((++_sp & 255u) == 0u) { if (xb_ld(&(bar)[XB_TMO])) break; if (_sp > XB_SPIN_CAP) { atomicAdd(&(bar)[XB_TMO], 1u); break; } } } } while (0)
struct XcdBarrier { unsigned* bar; unsigned x; volatile LAS unsigned* st; };
__device__ __forceinline__ XcdBarrier xcd_barrier_post(unsigned* bar, volatile LAS unsigned* st) {
    XcdBarrier b; b.bar = bar; b.x = xb_xcc_id(); b.st = st;
    if (threadIdx.x == 0) (void)xb_add(&bar[XB_XCNT(b.x)], 1u);
    return b;
}
__device__ __forceinline__ void xcd_barrier_complete(unsigned* bar, unsigned x, unsigned& nloc, unsigned& nx) {
    const unsigned G = gridDim.x * gridDim.y * gridDim.z;
    unsigned sum, cnt, mine, sp = 0u;
    for (;;) {
        sum = 0u; cnt = 0u; mine = 0u;
#pragma unroll
        for (unsigned j = 0; j < 16; ++j) { const unsigned c = xb_ld(&bar[XB_XCNT(j)]); sum += c; cnt += (c > 0u) ? 1u : 0u; mine = (j == x) ? c : mine; }
        if (sum == G) break;
        __builtin_amdgcn_s_sleep(1);
        if ((++sp & 255u) == 0u) { if (xb_ld(&bar[XB_TMO])) break; if (sp > XB_SPIN_CAP) { atomicAdd(&bar[XB_TMO], 1u); break; } }
    }
    nloc = mine > 0u ? mine : 1u; nx = cnt > 0u ? cnt : 1u;
}
__device__ __forceinline__ void xcd_barrier(const XcdBarrier& b, const int tid) {
    asm volatile("s_waitcnt vmcnt(0)" ::: "memory");
    __syncthreads();
    if (tid == 0) {
        unsigned* bar = b.bar;
        __builtin_amdgcn_s_waitcnt(0);
        unsigned nloc = b.st[0], nx = b.st[1];
        if (nloc == 0u) { xcd_barrier_complete(bar, b.x, nloc, nx); b.st[0] = nloc; b.st[1] = nx; }
        const unsigned old = xb_add(&bar[XB_XSUB(b.x)], 1u);
        const unsigned gen = old / nloc;
        if (old + 1u == (gen + 1u) * nloc) {
            __builtin_amdgcn_fence(__ATOMIC_RELEASE, "agent");
            asm volatile("s_waitcnt vmcnt(0)" ::: "memory");
            const unsigned og = xb_add(&bar[XB_TOP], 1u);
            const unsigned tg = og / nx;
            if (og + 1u == (tg + 1u) * nx) xb_add(&bar[XB_TOPGEN], 1u);
            else XB_SPIN(xb_ld(&bar[XB_TOPGEN]) == tg, bar);
            __builtin_amdgcn_fence(__ATOMIC_ACQUIRE, "agent");
            xb_add(&bar[XB_XGEN(b.x)], 1u);
            asm volatile("s_waitcnt vmcnt(0)" ::: "memory");
        } else {
            XB_SPIN(xb_ld(&bar[XB_XGEN(b.x)]) == gen, bar);
            __builtin_amdgcn_fence(__ATOMIC_ACQUIRE, "agent");
            asm volatile("s_waitcnt vmcnt(0)" ::: "memory");
        }
    }
    __syncthreads();
}

struct Args { const float* in[23]; float* out; unsigned char* ws; int ph_lo, ph_hi; };
enum { I_X = 0, I_MEM, I_NMIX, I_WIN, I_RELA, I_T5, I_DLAM, I_SUBLN, I_WOUT, I_NCROSS, I_NMEM, I_WXQ, I_WXKV, I_WXO, I_NFFN, I_WG, I_BG, I_WE, I_BE, I_W1, I_W3, I_W2, I_NFIN };

struct Ctx {
    const __attribute__((address_space(4))) unsigned char* ka;
    float* out; GAS unsigned char* ws;
    LAS unsigned char* lds;
    int tid, lane, wave, gw, ngw;
};
#define WSP(type, off) ((type*)(GAS type*)(C.ws + (off)))
#define CIN(i) ((const float*)*(const GAS float* const __attribute__((address_space(4)))*)(C.ka + 8 * (i)))

DI unsigned cvtpk_rne(float lo, float hi) { unsigned r; asm volatile("v_cvt_pk_bf16_f32 %0, %1, %2" : "=v"(r) : "v"(lo), "v"(hi)); return r; }
DI unsigned pk8(float a, float b, float c, float d) { int r = __builtin_amdgcn_cvt_pk_fp8_f32(a, b, 0, false); r = __builtin_amdgcn_cvt_pk_fp8_f32(c, d, r, true); return (unsigned)r; }
DI float clamp8(float v) { return __builtin_amdgcn_fmed3f(v, -448.f, 448.f); }
constexpr float W8S = 64.f;
template <bool F8 = false> DI void tr_item(const float* src, int ldsrc, int k0, int n0, const float* gk, float nscale, void* dst_, int lddst, int drow0, int lane) {
    bf16_t* dst = (bf16_t*)dst_;
    const int n4 = lane & 15, kg = lane >> 4;
    const float* sp = src + (size_t)(k0 + kg * 16) * ldsrc + n0 + 4 * n4;
    f32x4 v[16];
#pragma unroll
    for (int j = 0; j < 16; ++j) v[j] = __builtin_nontemporal_load((const f32x4*)(sp + (size_t)j * ldsrc));
    float g[16];
    if (gk) {
#pragma unroll
        for (int j4 = 0; j4 < 4; ++j4) { const f32x4 t = *(const f32x4*)(gk + k0 + kg * 16 + 4 * j4); g[4 * j4] = t.x * nscale; g[4 * j4 + 1] = t.y * nscale; g[4 * j4 + 2] = t.z * nscale; g[4 * j4 + 3] = t.w * nscale; }
    } else {
#pragma unroll
        for (int j = 0; j < 16; ++j) g[j] = nscale;
    }
    if constexpr (F8) { unsigned char* dp8 = (unsigned char*)dst_ + (size_t)(drow0 + 4 * n4) * lddst + k0 + kg * 16;
#pragma unroll
        for (int q = 0; q < 4; ++q) { u32x4 o;
#pragma unroll
            for (int c = 0; c < 4; ++c) o[c] = pk8(v[4 * c][q] * g[4 * c], v[4 * c + 1][q] * g[4 * c + 1], v[4 * c + 2][q] * g[4 * c + 2], v[4 * c + 3][q] * g[4 * c + 3]);
            *(u32x4*)(dp8 + (size_t)q * lddst) = o; }
        return; }
    bf16_t* dp = dst + (size_t)(drow0 + 4 * n4) * lddst + k0 + kg * 16;
#pragma unroll
    for (int q = 0; q < 4; ++q)
#pragma unroll
        for (int c = 0; c < 2; ++c) { u32x4 o;
            o.x = cvtpk_rne(v[8 * c][q] * g[8 * c], v[8 * c + 1][q] * g[8 * c + 1]); o.y = cvtpk_rne(v[8 * c + 2][q] * g[8 * c + 2], v[8 * c + 3][q] * g[8 * c + 3]);
            o.z = cvtpk_rne(v[8 * c + 4][q] * g[8 * c + 4], v[8 * c + 5][q] * g[8 * c + 5]); o.w = cvtpk_rne(v[8 * c + 6][q] * g[8 * c + 6], v[8 * c + 7][q] * g[8 * c + 7]);
            *(u32x4*)(dp + (size_t)q * lddst + 8 * c) = o; }
}

DI int t5_bucket(int rel) {
    const int ret = rel > 0 ? 16 : 0; const int n = rel < 0 ? -rel : rel;
    const float nf = (float)(n > 8 ? n : 8);
    int large = 8 + (int)(logf(nf / 8.f) / logf(64.f) * 8.f);
    large = large < 15 ? large : 15;
    return ret + (n < 8 ? n : large);
}

constexpr int LI_WIN = 32 * 96, LI_WOUT = 1024, LI_W13 = NE * 128, LI_W2 = NE * 128, LAYER_ITEMS = LI_WIN + LI_WOUT + LI_W13 + LI_W2;
DI void convert_layer_item(const Ctx& C, int l, int it, int lane) {
    if (it < LI_WIN) { const int kb = it / 96, nb = it % 96, n0 = nb * 64;
        if (l >= L8) { tr_item<true>(CIN(I_WIN) + (size_t)l * D * INW, INW, kb * 64, n0, CIN(I_NMIX) + l * D, W8S, (unsigned char*)(WSP(bf16_t, WS_WIN) + (size_t)l * INW * D), D, n0, lane); return; }
        const float ns = (n0 < 1024) ? SC_A : ((n0 >= 3072 && n0 < 4096) ? SC_B : 1.f);
        tr_item(CIN(I_WIN) + (size_t)l * D * INW, INW, kb * 64, n0, CIN(I_NMIX) + l * D, ns, WSP(bf16_t, WS_WIN) + (size_t)l * INW * D, D, n0, lane); return; }
    it -= LI_WIN;
    if (it < LI_WOUT) { const int kb = it / 32, nb = it % 32;
        if (l >= L8B) { tr_item<true>(CIN(I_WOUT) + (size_t)l * D * D, D, kb * 64, nb * 64, nullptr, W8S, (unsigned char*)(WSP(bf16_t, WS_WOUT) + (size_t)l * D * D), D, nb * 64, lane); return; }
        tr_item(CIN(I_WOUT) + (size_t)l * D * D, D, kb * 64, nb * 64, nullptr, 1.f, WSP(bf16_t, WS_WOUT) + (size_t)l * D * D, D, nb * 64, lane); return; }
    it -= LI_WOUT;
    if (it < LI_W13) { const int le = l * NE + it / 128, r = it % 128, kb = r / 4, nb = r % 4;
        bf16_t* dst = WSP(bf16_t, WS_W13) + (size_t)le * 512 * D; const int dr = (nb >> 1) * 256 + (nb & 1) * 64;
        if (l >= L8M) { unsigned char* d8 = (unsigned char*)(WSP(bf16_t, WS_W13) + (size_t)l * NE * 512 * D) + (size_t)(it / 128) * 512 * D;
            tr_item<true>(CIN(I_W1) + (size_t)le * D * DE, DE, kb * 64, nb * 64, CIN(I_NFFN) + l * D, W8S, d8, D, dr, lane);
            tr_item<true>(CIN(I_W3) + (size_t)le * D * DE, DE, kb * 64, nb * 64, CIN(I_NFFN) + l * D, W8S, d8, D, dr + 128, lane); return; }
        tr_item(CIN(I_W1) + (size_t)le * D * DE, DE, kb * 64, nb * 64, CIN(I_NFFN) + l * D, 1.f, dst, D, dr, lane);
        tr_item(CIN(I_W3) + (size_t)le * D * DE, DE, kb * 64, nb * 64, CIN(I_NFFN) + l * D, 1.f, dst, D, dr + 128, lane); return; }
    it -= LI_W13;
    { const int le = l * NE + it / 128, r = it % 128, kb = r / 32, nb = r % 32;
      if (l >= L8M) { tr_item<true>(CIN(I_W2) + (size_t)le * DE * D, D, kb * 64, nb * 64, nullptr, W8S, (unsigned char*)(WSP(bf16_t, WS_W2) + (size_t)l * NE * D * DE) + (size_t)(it / 128) * D * DE, DE, nb * 64, lane); return; }
      tr_item(CIN(I_W2) + (size_t)le * DE * D, D, kb * 64, nb * 64, nullptr, 1.f, WSP(bf16_t, WS_W2) + (size_t)le * D * DE, DE, nb * 64, lane); }
}
DI void convert_pull(const Ctx& C, int l, int quota, const unsigned* stop) {
    unsigned* qh = WSP(unsigned, WS_CTL) + CW_QH + l;
    for (int n = 0; n < quota; n += 4) {
        unsigned it = 0, st = 0;
        if (C.lane == 0) { if (stop) st = __hip_atomic_load(stop, __ATOMIC_RELAXED, __HIP_MEMORY_SCOPE_AGENT);
                           it = __hip_atomic_fetch_add(qh, 4u, __ATOMIC_RELAXED, __HIP_MEMORY_SCOPE_AGENT); }
        it = (unsigned)__builtin_amdgcn_readfirstlane((int)it); st = (unsigned)__builtin_amdgcn_readfirstlane((int)st);
        if (it >= (unsigned)LAYER_ITEMS) break;
        for (int k = 0; k < 4; ++k) convert_layer_item(C, l, (int)it + k, C.lane);
        if (st != 0u) break;
    }
}
static_assert(LAYER_ITEMS % 4 == 0, "queue batches of 4");
DI void phase_prologue(const Ctx& C) {
    const int gw = C.gw, ngw = C.ngw, lane = C.lane;
    for (int it = gw; it < LAYER_ITEMS; it += ngw) convert_layer_item(C, 0, it, lane);
    for (int it = gw; it < NL * 2048; it += ngw) { const int l = it / 2048, r = it % 2048, kb = r / 64, nb = r % 64;
        tr_item<true>(CIN(I_WXKV) + (size_t)l * D * 4096, 4096, kb * 64, nb * 64, CIN(I_NMEM) + l * D, W8S, WSP(unsigned char, WS_WKV) + (size_t)l * 4096 * D, D, nb * 64, lane); }
    for (int it = gw; it < NL * 1024; it += ngw) { const int l = it / 1024, r = it % 1024, kb = r / 32, nb = r % 32;
        tr_item<true>(CIN(I_WXO) + (size_t)l * D * D, D, kb * 64, nb * 64, nullptr, W8S, WSP(unsigned char, WS_WXO) + (size_t)l * D * D, D, nb * 64, lane); }
    { const size_t n8 = (size_t)NL * D * D / 8; const float* src = CIN(I_WXQ); unsigned char* dst = WSP(unsigned char, WS_WQS);
      for (size_t i = (size_t)gw * 64 + lane; i < n8; i += (size_t)ngw * 64) { const size_t e = i * 8; const int row = (int)((e / D) % D), l = (int)(e / ((size_t)D * D));
          const float sc = CIN(I_NCROSS)[l * D + row] * (SC_X * Q8S); const f32x4 a = __builtin_nontemporal_load((const f32x4*)(src + e)), b = __builtin_nontemporal_load((const f32x4*)(src + e + 4));
          u32x2 o; o.x = pk8(a.x * sc, a.y * sc, a.z * sc, a.w * sc); o.y = pk8(b.x * sc, b.y * sc, b.z * sc, b.w * sc);
          *(u32x2*)(dst + e) = o; } }
    { bf16_t* whi = WSP(bf16_t, WS_WRT); bf16_t* wlo = whi + (size_t)NL * 64 * D;
      for (int i = gw * 64 + lane; i < NL * 64 * D; i += ngw * 64) { const int l = i / (64 * D), rem = i % (64 * D), f = rem >> 9, L = (rem >> 3) & 63, jj = rem & 7;
          const int blk = f & 1, s16 = (f >> 1) & 15, w8 = f >> 5, j = blk * 32 + (L & 31), k = w8 * 256 + s16 * 16 + 8 * (L >> 5) + jj;
          float w = 0.f;
          if (j < 36) w = (j < 4 ? CIN(I_WG)[((size_t)l * D + k) * 4 + j] : CIN(I_WE)[((size_t)l * D + k) * 32 + (j - 4)]) * CIN(I_NFFN)[l * D + k];
          const unsigned h = f2bf(w); whi[i] = (bf16_t)h; wlo[i] = (bf16_t)f2bf(w - __uint_as_float(h << 16)); } }
    { bf16_t* xb = WSP(bf16_t, WS_XB); float* part = WSP(float, WS_PART);
      for (int row = gw; row < T + MT; row += ngw) {
          const bool isx = row < T; const int rr = isx ? row : row - T;
          const float* src = (isx ? CIN(I_X) : CIN(I_MEM)) + (size_t)rr * D; bf16_t* dst = (isx ? xb : WSP(bf16_t, WS_MEMB)) + (size_t)rr * D;
          float ss = 0.f; f32x4 vv[8];
#pragma unroll
          for (int j = 0; j < 8; ++j) vv[j] = __builtin_nontemporal_load((const f32x4*)(src + j * 256 + lane * 4));
          __builtin_amdgcn_sched_barrier(0);
#pragma unroll
          for (int j = 0; j < 8; ++j) { const f32x4 v = vv[j];
              u32x2 o; o.x = pk2(v.x, v.y); o.y = pk2(v.z, v.w);
              if (isx) *(u32x2*)(dst + j * 256 + lane * 4) = o;
              else *(unsigned*)(WSP(unsigned char, WS_MEMB) + (size_t)rr * D + j * 256 + lane * 4) = pk8(clamp8(v.x), clamp8(v.y), clamp8(v.z), clamp8(v.w));
              const float a = bf2f((bf16_t)(o.x & 0xffff)), b = bf2f((bf16_t)(o.x >> 16)), c = bf2f((bf16_t)(o.y & 0xffff)), d = bf2f((bf16_t)(o.y >> 16));
              ss += (a * a + b * b) + (c * c + d * d); }
          ss = wave_sum(ss, C.lane);
          if (isx) { if (lane < 32) part[(size_t)rr * 32 + lane] = lane == 0 ? ss : 0.f; }
          else if (lane == 0) WSP(float, WS_RMEM)[rr] = rsqrtf(ss * (1.f / D) + EPS);
      } }
    if (blockIdx.x == 0) {
        float* tb = WSP(float, WS_TABB); float* ta = WSP(float, WS_TABA);
        for (int i = C.tid; i < 8 * TABB_N; i += NTHREADS) { const int h = i / TABB_N, idx = i % TABB_N; const int rel = idx - TABB_OFF;
            tb[i] = (rel <= 63) ? CIN(I_T5)[t5_bucket(rel) * 8 + h] * LOG2E : 0.f; }
        for (int i = C.tid; i < NL * 8 * TABA_N; i += NTHREADS) { const int idx = i % TABA_N, h = (i / TABA_N) % 8, l = i / (8 * TABA_N); int rel = idx - TABA_OFF; rel = rel > 128 ? 128 : (rel < -128 ? -128 : rel);
            ta[i] = CIN(I_RELA)[((size_t)l * 257 + (rel + 128)) * 8 + h] * LOG2E; }
        if (C.wave < NL) { const int l = C.wave; const float* lv = CIN(I_DLAM) + l * 256;
            const float s1 = wave_sum(lv[lane] * lv[64 + lane], C.lane), s2 = wave_sum(lv[128 + lane] * lv[192 + lane], C.lane);
            if (lane == 0) WSP(float, WS_LAM)[l] = expf(s1) - expf(s2) + (0.8f - 0.6f * expf(-0.3f * (float)l)); }
    }
}

DI void phase_router(const Ctx& C, int l) {
    const bf16_t* xb = WSP(bf16_t, WS_XB); const float* part = WSP(float, WS_PART);
    const bf16_t* whi = WSP(bf16_t, WS_WRT) + (size_t)l * 64 * D; const bf16_t* wlo = whi + (size_t)NL * 64 * D;
    unsigned* cnt = WSP(unsigned, WS_CTL) + CW_CNT + l * NE * CNT_STRIDE;
    int* ltok = WSP(int, WS_LTOK); float* lw = WSP(float, WS_LW); float* lr = WSP(float, WS_LR);
    const int lane = C.lane, wid = C.wave, r32 = lane & 31, hi = lane >> 5;
    LAS float* red = (LAS float*)C.lds;
    LAS float* lg = (LAS float*)(C.lds + 65536);
    volatile LAS unsigned* lcnt = (volatile LAS unsigned*)(C.lds + 65536 + 8192); volatile LAS unsigned* gbase = lcnt + 32;
    for (int tb = (int)blockIdx.x; tb < T / 32; tb += (int)gridDim.x) {
        const int t0 = tb * 32, k0 = wid * 256;
        f32x16 a0 = {}, a1 = {};
        const char* xp = (const char*)(xb + (size_t)t0 * D + k0); unsigned xo = (unsigned)(r32 * D + 8 * hi) * 2u;
        const char* wh = (const char*)(whi + (size_t)(wid * 32) * 512); const char* wl = (const char*)(wlo + (size_t)(wid * 32) * 512); unsigned wo = (unsigned)lane * 16u;
        bf16x8 xf[3][2], fh[3][4], fl[3][4];
#define RT_LOAD(bf, s2) do { asm volatile("" : "+v"(xo), "+v"(wo)); _Pragma("unroll") for (int q = 0; q < 2; ++q) xf[bf][q] = *(const bf16x8*)(xp + 32 * ((s2) + q) + xo); \
            _Pragma("unroll") for (int q = 0; q < 4; ++q) { fh[bf][q] = *(const bf16x8*)(wh + (2 * (s2) + q) * 1024 + wo); fl[bf][q] = *(const bf16x8*)(wl + (2 * (s2) + q) * 1024 + wo); } __builtin_amdgcn_sched_barrier(0); } while (0)
#define RT_MMA(bf) do { _Pragma("unroll") for (int q = 0; q < 2; ++q) { \
                a0 = MFMA32(fh[bf][2 * q], xf[bf][q], a0);     a0 = MFMA32(fl[bf][2 * q], xf[bf][q], a0); \
                a1 = MFMA32(fh[bf][2 * q + 1], xf[bf][q], a1); a1 = MFMA32(fl[bf][2 * q + 1], xf[bf][q], a1); } __builtin_amdgcn_sched_barrier(0); } while (0)
        RT_LOAD(0, 0); RT_LOAD(1, 2);
        RT_LOAD(2, 4);  RT_MMA(0);
        RT_LOAD(0, 6);  RT_MMA(1);
        RT_LOAD(1, 8);  RT_MMA(2);
        RT_LOAD(2, 10); RT_MMA(0);
        RT_LOAD(0, 12); RT_MMA(1);
        RT_LOAD(1, 14); RT_MMA(2);
        RT_MMA(0); RT_MMA(1);
#undef RT_LOAD
#undef RT_MMA
#pragma unroll
        for (int i = 0; i < 16; ++i) red[(wid * 36 + crow(i, hi)) * 32 + r32] = a0[i];
        if (hi == 0) {
#pragma unroll
            for (int i = 0; i < 4; ++i) red[(wid * 36 + 32 + i) * 32 + r32] = a1[i];
        }
        AT_BAR();
        if (wid == 0) {
            if (lane < 32) lcnt[lane] = 0u;
            const f32x4* pp = (const f32x4*)(part + (size_t)(t0 + r32) * 32); float ps = 0.f;
#pragma unroll
            for (int q = 0; q < 8; ++q) { const f32x4 v = pp[q]; ps += (v.x + v.y) + (v.z + v.w); }
            const float rs = rsqrtf(ps * (1.f / D) + EPS);
#pragma unroll
            for (int oo = 0; oo < 18; ++oo) { const int o = hi * 18 + oo; float sacc = 0.f;
#pragma unroll
                for (int w = 0; w < 8; ++w) sacc += red[(w * 36 + o) * 32 + r32];
                lg[r32 * 40 + o] = sacc * rs + (o < 4 ? CIN(I_BG)[l * 4 + o] : CIN(I_BE)[l * 32 + (o - 4)]); }
            LDS_WAIT();
            if (hi == 0) {
                const LAS float* my = lg + r32 * 40; const int t = t0 + r32;
                const float g0 = my[0], g1 = my[1], g2 = my[2], g3 = my[3];
                int gs = 0; float gm = g0; if (g1 > gm) { gm = g1; gs = 1; } if (g2 > gm) { gm = g2; gs = 2; } if (g3 > gm) { gm = g3; gs = 3; }
                const float gate = 1.f / (expf(g0 - gm) + expf(g1 - gm) + expf(g2 - gm) + expf(g3 - gm));
                float v0 = -3.0e38f, v1 = -3.0e38f; int i0 = 0, i1 = 0;
#pragma unroll
                for (int i = 0; i < 8; ++i) { const float v = my[4 + gs * 8 + i];
                    if (v > v0) { v1 = v0; i1 = i0; v0 = v; i0 = i; } else if (v > v1) { v1 = v; i1 = i; } }
                const float e = expf(v1 - v0), w0 = gate / (1.f + e), w1 = gate * e / (1.f + e);
                const int ea = gs * 8 + i0, eb = gs * 8 + i1;
                const unsigned la = __hip_atomic_fetch_add((LAS unsigned*)lcnt + ea, 1u, __ATOMIC_RELAXED, __HIP_MEMORY_SCOPE_WORKGROUP), lb = __hip_atomic_fetch_add((LAS unsigned*)lcnt + eb, 1u, __ATOMIC_RELAXED, __HIP_MEMORY_SCOPE_WORKGROUP);
                LDS_WAIT();
                { const unsigned mine = lcnt[r32]; unsigned gb = 0u; if (mine) gb = atomicAdd(&cnt[r32 * CNT_STRIDE], mine); gbase[r32] = gb; }
                LDS_WAIT();
                const unsigned pa = gbase[ea] + la, pb = gbase[eb] + lb;
                ltok[(size_t)ea * T + pa] = t * 2;     lw[(size_t)ea * T + pa] = w0; lr[(size_t)ea * T + pa] = rs;
                ltok[(size_t)eb * T + pb] = t * 2 + 1; lw[(size_t)eb * T + pb] = w1; lr[(size_t)eb * T + pb] = rs;
            }
        }
        AT_BAR();
    }
}
DI void phase_combine(const Ctx& C, int l) {
    bf16_t* xb = WSP(bf16_t, WS_XB); const bf16_t* Y = WSP(bf16_t, WS_Y); float* part = WSP(float, WS_PART);
    for (int row = C.gw; row < T; row += C.ngw) {
        float xv[32]; float ss = 0.f;
#pragma unroll
        for (int j = 0; j < 4; ++j) { const size_t o = (size_t)row * D + j * 512 + C.lane * 8;
            const u32x4 a = __builtin_nontemporal_load((const u32x4*)(xb + o)); const u32x2 y0 = __builtin_nontemporal_load((const u32x2*)((const unsigned char*)Y + o)), y1 = __builtin_nontemporal_load((const u32x2*)((const unsigned char*)Y + (size_t)T * D + o));
#pragma unroll
            for (int h2 = 0; h2 < 2; ++h2) { const int w0 = (int)y0[h2], w1 = (int)y1[h2];
                const auto l0 = __builtin_amdgcn_cvt_pk_f32_fp8(w0, false), u0 = __builtin_amdgcn_cvt_pk_f32_fp8(w0, true), l1 = __builtin_amdgcn_cvt_pk_f32_fp8(w1, false), u1 = __builtin_amdgcn_cvt_pk_f32_fp8(w1, true);
                xv[j * 8 + 4 * h2]     = __uint_as_float(a[2 * h2] << 16)               + (l0[0] + l1[0]) * (1.f / Y8S);
                xv[j * 8 + 4 * h2 + 1] = __uint_as_float(a[2 * h2] & 0xffff0000u)       + (l0[1] + l1[1]) * (1.f / Y8S);
                xv[j * 8 + 4 * h2 + 2] = __uint_as_float(a[2 * h2 + 1] << 16)           + (u0[0] + u1[0]) * (1.f / Y8S);
                xv[j * 8 + 4 * h2 + 3] = __uint_as_float(a[2 * h2 + 1] & 0xffff0000u)   + (u0[1] + u1[1]) * (1.f / Y8S); } }
        if (l == NL - 1) {
#pragma unroll
            for (int i = 0; i < 32; ++i) ss += xv[i] * xv[i];
            const float rs = rsqrtf(wave_sum(ss, C.lane) * (1.f / D) + EPS);
#pragma unroll
            for (int j = 0; j < 4; ++j) { const int col = j * 512 + C.lane * 8; const f32x4 g0 = *(const f32x4*)(CIN(I_NFIN) + col), g1 = *(const f32x4*)(CIN(I_NFIN) + col + 4);
                f32x4 o0, o1; o0.x = xv[j * 8] * rs * g0.x; o0.y = xv[j * 8 + 1] * rs * g0.y; o0.z = xv[j * 8 + 2] * rs * g0.z; o0.w = xv[j * 8 + 3] * rs * g0.w;
                o1.x = xv[j * 8 + 4] * rs * g1.x; o1.y = xv[j * 8 + 5] * rs * g1.y; o1.z = xv[j * 8 + 6] * rs * g1.z; o1.w = xv[j * 8 + 7] * rs * g1.w;
                *(f32x4*)(C.out + (size_t)row * D + col) = o0; *(f32x4*)(C.out + (size_t)row * D + col + 4) = o1; }
        } else {
#pragma unroll
            for (int j = 0; j < 4; ++j) { u32x4 o;
#pragma unroll
                for (int q = 0; q < 4; ++q) { o[q] = pk2(xv[j * 8 + 2 * q], xv[j * 8 + 2 * q + 1]);
                    const float a = __uint_as_float(o[q] << 16), b = __uint_as_float(o[q] & 0xffff0000u); ss += a * a + b * b; }
                __builtin_nontemporal_store(o, (u32x4*)(xb + (size_t)row * D + j * 512 + C.lane * 8));
                if (l + 1 >= L8) { u32x2 e; e.x = pk8(clamp8(xv[j * 8]), clamp8(xv[j * 8 + 1]), clamp8(xv[j * 8 + 2]), clamp8(xv[j * 8 + 3])); e.y = pk8(clamp8(xv[j * 8 + 4]), clamp8(xv[j * 8 + 5]), clamp8(xv[j * 8 + 6]), clamp8(xv[j * 8 + 7]));
                __builtin_nontemporal_store(e, (u32x2*)(WSP(unsigned char, WS_X8) + (size_t)row * D + j * 512 + C.lane * 8)); } }
            ss = wave_sum(ss, C.lane);
            if (C.lane < 32) part[(size_t)row * 32 + C.lane] = C.lane == 0 ? ss : 0.f;
        }
    }
}

typedef short s16x4 __attribute__((ext_vector_type(4)));
#define AT_KSWZ(row, colB) ((row) * 256 + ((colB) ^ (((row) & 7) << 4)))
DI int at_v_rd_base(int lane) { return ((lane & 3) << 3) | (((lane >> 2) & 3) << 6) | (((lane >> 4) & 1) << 5) | (((lane >> 5) & 1) << 8); }
template <int OFF> DI s16x4 at_tr_read(int vb) { s16x4 r; asm volatile("ds_read_b64_tr_b16 %0, %1 offset:%2" : "=&v"(r) : "v"(vb), "i"(OFF) : "memory"); return r; }
DI unsigned at_cvtpk(float lo, float hi) { unsigned r; asm volatile("v_cvt_pk_bf16_f32 %0, %1, %2" : "=v"(r) : "v"(lo), "v"(hi)); return r; }
constexpr float AT_THR = 8.f;

template <int KS> DI void at_qk(f32x16& p0, f32x16& p1, LAS const unsigned char* Kt, int mapB, const bf16x8 (&qr)[8], float init, int r32, int hi) {
#pragma unroll
    for (int i = 0; i < 16; ++i) { p0[i] = init; p1[i] = init; }
    bf16x8 kb[KS][2];
#pragma unroll
    for (int d0 = 0; d0 < KS; ++d0) { const int cb = mapB + (d0 * 16 + hi * 8) * 2;
        kb[d0][0] = *(const LAS bf16x8*)(Kt + AT_KSWZ(r32, cb)); kb[d0][1] = *(const LAS bf16x8*)(Kt + AT_KSWZ(32 + r32, cb)); }
    __builtin_amdgcn_sched_barrier(0);
#pragma unroll
    for (int d0 = 0; d0 < KS; ++d0) { p0 = MFMA32(kb[d0][0], qr[d0], p0); p1 = MFMA32(kb[d0][1], qr[d0], p1); }
}
DI float at_softmax(f32x16& p0, f32x16& p1, float& m_run, bool first, bool nearb, LAS const float* tabp, int lane) {
    if (nearb) {
#pragma unroll
        for (int i = 0; i < 16; ++i) { p0[i] += tabp[8 * (i >> 2) + (i & 3)]; p1[i] += tabp[32 + 8 * (i >> 2) + (i & 3)]; }
    }
    float mx = p0[0];
#pragma unroll
    for (int i = 1; i < 16; ++i) mx = fmaxf(mx, p0[i]);
#pragma unroll
    for (int i = 0; i < 16; ++i) mx = fmaxf(mx, p1[i]);
    float alpha = 1.f;
    if (first || !__all(mx <= AT_THR)) {
        mx = max_x32(mx, lane);
        const float dl = first ? mx : fmaxf(mx, 0.f);
        alpha = first ? 1.f : __builtin_amdgcn_exp2f(-dl); m_run += dl;
#pragma unroll
        for (int i = 0; i < 16; ++i) { p0[i] -= dl; p1[i] -= dl; }
    }
#pragma unroll
    for (int i = 0; i < 16; ++i) p0[i] = __builtin_amdgcn_exp2f(p0[i]);
#pragma unroll
    for (int i = 0; i < 16; ++i) p1[i] = __builtin_amdgcn_exp2f(p1[i]);
    return alpha;
}
DI bf16x8 at_pack(const f32x16& p, int s8) {
    u32x4 w; w.x = at_cvtpk(p[s8], p[s8 + 1]); w.y = at_cvtpk(p[s8 + 2], p[s8 + 3]); w.z = at_cvtpk(p[s8 + 4], p[s8 + 5]); w.w = at_cvtpk(p[s8 + 6], p[s8 + 7]);
    return __builtin_bit_cast(bf16x8, w);
}
template <int D0> DI void at_pv_block(f32x16 (&o)[4], int vb, const bf16x8 (&pf)[4]) {
    const s16x4 l0 = at_tr_read<D0 * 512 + 0 * 4096>(vb), h0 = at_tr_read<D0 * 512 + 0 * 4096 + 2048>(vb), l1 = at_tr_read<D0 * 512 + 1 * 4096>(vb), h1 = at_tr_read<D0 * 512 + 1 * 4096 + 2048>(vb);
    const s16x4 l2 = at_tr_read<D0 * 512 + 2 * 4096>(vb), h2 = at_tr_read<D0 * 512 + 2 * 4096 + 2048>(vb), l3 = at_tr_read<D0 * 512 + 3 * 4096>(vb), h3 = at_tr_read<D0 * 512 + 3 * 4096 + 2048>(vb);
    asm volatile("s_waitcnt lgkmcnt(0)" ::: "memory"); __builtin_amdgcn_sched_barrier(0);
#define AT_PK(L, H) (bf16x8){L[0], L[1], L[2], L[3], H[0], H[1], H[2], H[3]}
    o[D0] = MFMA32(AT_PK(l0, h0), pf[0], o[D0]); o[D0] = MFMA32(AT_PK(l1, h1), pf[1], o[D0]); o[D0] = MFMA32(AT_PK(l2, h2), pf[2], o[D0]); o[D0] = MFMA32(AT_PK(l3, h3), pf[3], o[D0]);
#undef AT_PK
}

DI void at_store_rows8(const unsigned (&pk)[4][4], LAS unsigned char* wst, unsigned char* out_row0, int r32, int hi, int lane) {
#pragma unroll
    for (int d0 = 0; d0 < 4; ++d0)
#pragma unroll
        for (int gq = 0; gq < 4; ++gq) *(LAS unsigned*)(wst + r32 * 144 + 32 * d0 + 8 * gq + 4 * hi) = pk[d0][gq];
    LDS_WAIT();
#pragma unroll
    for (int k = 0; k < 4; ++k) { const int idx = k * 64 + lane, row = idx >> 3, c = idx & 7;
        const u32x4 v = *(const LAS u32x4*)(wst + row * 144 + c * 16);
        *(u32x4*)(out_row0 + (size_t)row * D + c * 16) = v; }
}
DI void at_store_rows(const u32x2 (&pk)[4][4], LAS unsigned char* wst, bf16_t* out_row0  , int r32, int hi, int lane) {
#pragma unroll
    for (int d0 = 0; d0 < 4; ++d0)
#pragma unroll
        for (int gq = 0; gq < 4; ++gq) *(LAS u32x2*)(wst + r32 * 272 + (32 * d0 + 8 * gq + 4 * hi) * 2) = pk[d0][gq];
    LDS_WAIT();
#pragma unroll
    for (int k = 0; k < 8; ++k) { const int idx = k * 64 + lane, row = idx >> 4, c = idx & 15;
        const u32x4 v = *(const LAS u32x4*)(wst + row * 272 + c * 16);
        *(u32x4*)(out_row0 + (size_t)row * D + c * 8) = v; }
}
DI void at_stage1(LAS unsigned char* lds, const char* projb, int kcolB, int vcolB, int kt, int slot, int wid, unsigned lb0, unsigned lb1) {
    const int kv = wid >> 2, sub0 = (wid & 3) * 4;
    LAS unsigned char* dst = lds + slot * 32768 + kv * 16384 + sub0 * 1024;
    const char* tb = projb + (size_t)kt * 64 * (INW * 2) + (kv ? vcolB : kcolB);
#pragma unroll
    for (int n = 0; n < 4; ++n) { const int sub = sub0 + n;
        const size_t U = kv ? (size_t)((sub >> 1) * 8) * (INW * 2) + (size_t)((sub & 1) * 128) : (size_t)(sub * 4) * (INW * 2);
        __builtin_amdgcn_global_load_lds((const unsigned*)(tb + U + ((n & 1) ? lb1 : lb0)), (LAS unsigned*)(dst + n * 1024), 16, 0, 0); }
}
DI void attn_unit_diff(const Ctx& C, int l, int b, int h, int j) {
    constexpr int KS = 4;
    int lane_ = C.lane; asm volatile("" : "+v"(lane_));
    const int lane = lane_, wid = C.wave, g = wid >> 2, wq = wid & 3, r32 = lane & 31, hi = lane >> 5;
    const int qcol = 3072 + h * 128 + g * 64, kcolB = (4096 + h * 128) * 2, vcolB = (5120 + h * 128) * 2;
    const bf16_t* proj = WSP(bf16_t, WS_PROJ);
    const size_t rowb = (size_t)b * SEQ;
    const char* projb = (const char*)(proj + rowb * INW);
    const int nt = 2 * j + 2;
    const int cw = 2 * j + (wq >> 1), q0w = j * 128 + wq * 32, qpos = q0w + r32;
    const float* tabg = WSP(float, WS_TABB) + h * TABB_N;
    LAS float* tabl = (LAS float*)(C.lds + 131072);
    AT_BAR();
    for (int i = wid * 64 + lane; i < TABB_N; i += NTHREADS) tabl[i] = tabg[i];
    bf16x8 qr[8];
    { const bf16_t* qp = proj + (rowb + qpos) * INW + qcol + 8 * hi;
#pragma unroll
      for (int s = 0; s < KS; ++s) qr[s] = *(const bf16x8*)(qp + 16 * s); }
    unsigned lb0, lb1;
    { const int kv = wid >> 2;
      if (kv == 0) { const int rl = lane >> 4, cp = lane & 15; lb0 = (unsigned)(rl * (INW * 2) + ((cp ^ (rl & 7)) * 16)); lb1 = (unsigned)(rl * (INW * 2) + ((cp ^ ((4 + rl) & 7)) * 16)); }
      else { lb0 = (unsigned)(((lane & 31) >> 2) * (INW * 2) + ((lane >> 5) * 32 + (lane & 3) * 8) * 2); lb1 = lb0; } }
    at_stage1(C.lds, projb, kcolB, vcolB, 0, 0, wid, lb0, lb1);
    at_stage1(C.lds, projb, kcolB, vcolB, 1, 1, wid, lb0, lb1);
    f32x16 o[4], ol = {}; float m_run = 0.f; bool first = true;
#pragma unroll
    for (int d0 = 0; d0 < 4; ++d0) o[d0] = f32x16{};
    const bf16x8 ones = {16256, 16256, 16256, 16256, 16256, 16256, 16256, 16256};
    asm volatile("s_waitcnt vmcnt(4) lgkmcnt(0)\n\ts_barrier" ::: "memory");
    const float cfar = tabl[0];
    const int vrd = at_v_rd_base(lane);
    for (int sd = 0; sd < nt; ++sd) {
        const int slot = sd % 3;
        const bool staged = sd + 2 < nt;
        if (staged) at_stage1(C.lds, projb, kcolB, vcolB, sd + 2, (sd + 2) % 3, wid, lb0, lb1);
        if (sd <= cw) {
            LAS const unsigned char* Kt = C.lds + slot * 32768;
            const int vb = (int)(size_t)(Kt + 16384) + vrd;
            const bool nearb = (sd * 64 + 63 - q0w) > -305;
            LAS const float* tabp = tabl + (sd * 64 - qpos + TABB_OFF + 4 * hi);
            f32x16 p0, p1;
            at_qk<KS>(p0, p1, Kt, g * 128, qr, (nearb ? 0.f : cfar) - m_run, r32, hi);
            const float alpha = at_softmax(p0, p1, m_run, first, nearb, tabp, lane);
            first = false;
            if (__any(alpha != 1.f)) {
                ol[0] *= alpha;
#pragma unroll
                for (int d0 = 0; d0 < 4; ++d0)
#pragma unroll
                    for (int i = 0; i < 16; ++i) o[d0][i] *= alpha;
            }
            bf16x8 pf[4];
            pf[0] = at_pack(p0, 0); pf[1] = at_pack(p0, 8); pf[2] = at_pack(p1, 0); pf[3] = at_pack(p1, 8);
            ol = MFMA32(ones, pf[0], ol); ol = MFMA32(ones, pf[1], ol); ol = MFMA32(ones, pf[2], ol); ol = MFMA32(ones, pf[3], ol);
            at_pv_block<0>(o, vb, pf); at_pv_block<1>(o, vb, pf); at_pv_block<2>(o, vb, pf); at_pv_block<3>(o, vb, pf);
        }
        if (staged) asm volatile("s_waitcnt vmcnt(4) lgkmcnt(0)\n\ts_barrier" ::: "memory");
        else        asm volatile("s_waitcnt vmcnt(0) lgkmcnt(0)\n\ts_barrier" ::: "memory");
    }
    const float inv = 1.f / ol[0];
    LAS float* cmb = (LAS float*)C.lds + (size_t)wq * (64 * 64);
    if (g == 1) {
#pragma unroll
        for (int d0 = 0; d0 < 4; ++d0)
#pragma unroll
            for (int i = 0; i < 16; ++i) cmb[(d0 * 16 + i) * 64 + lane] = o[d0][i] * inv;
    }
    AT_BAR();
    if (g == 0) {
        const float lam = WSP(float, WS_LAM)[l]; float ss = 0.f;
#pragma unroll
        for (int d0 = 0; d0 < 4; ++d0)
#pragma unroll
            for (int i = 0; i < 16; ++i) { const float v = o[d0][i] * inv - lam * cmb[(d0 * 16 + i) * 64 + lane]; o[d0][i] = v; ss += v * v; }
        ss = sum_x32(ss, lane);
        const float lam_init = 0.8f - 0.6f * expf(-0.3f * (float)l);
        const float rn = rsqrtf(ss * (1.f / 128.f) + EPS) * (1.f - lam_init);
        const float* sg = CIN(I_SUBLN) + l * 128;
        if (l >= L8B) { unsigned pk8v[4][4];
#pragma unroll
            for (int d0 = 0; d0 < 4; ++d0)
#pragma unroll
                for (int gq = 0; gq < 4; ++gq) { const int d = 32 * d0 + 8 * gq + 4 * hi; const f32x4 gv = *(const f32x4*)(sg + d);
                    pk8v[d0][gq] = pk8(clamp8(o[d0][4 * gq] * rn * gv.x), clamp8(o[d0][4 * gq + 1] * rn * gv.y), clamp8(o[d0][4 * gq + 2] * rn * gv.z), clamp8(o[d0][4 * gq + 3] * rn * gv.w)); }
            at_store_rows8(pk8v, C.lds + 65536 + wq * 8704, WSP(unsigned char, WS_MIX) + (rowb + q0w) * D + 1024 + h * 128, r32, hi, lane);
        } else {
        u32x2 pk[4][4];
#pragma unroll
        for (int d0 = 0; d0 < 4; ++d0)
#pragma unroll
            for (int gq = 0; gq < 4; ++gq) { const int d = 32 * d0 + 8 * gq + 4 * hi; const f32x4 gv = *(const f32x4*)(sg + d);
                pk[d0][gq].x = at_cvtpk(o[d0][4 * gq] * rn * gv.x, o[d0][4 * gq + 1] * rn * gv.y); pk[d0][gq].y = at_cvtpk(o[d0][4 * gq + 2] * rn * gv.z, o[d0][4 * gq + 3] * rn * gv.w); }
        at_store_rows(pk, C.lds + 65536 + wq * 8704, WSP(bf16_t, WS_MIX) + (rowb + q0w) * D + 1024 + h * 128, r32, hi, lane); }
    }
}
DI void attn_unit_band(const Ctx& C, int l, int b, int h, int qt) {
    constexpr int KS = 8;
    int lane_ = C.lane; asm volatile("" : "+v"(lane_));
    const int lane = lane_, wid = C.wave, r32 = lane & 31, hi = lane >> 5;
    const int qcol = h * 128, kcolB = (1024 + h * 128) * 2, vcolB = (2048 + h * 128) * 2;
    const bf16_t* proj = WSP(bf16_t, WS_PROJ);
    const size_t rowb = (size_t)b * SEQ;
    const char* projb = (const char*)(proj + rowb * INW);
    const int kt_hi = 4 * qt + 3, kt_lo = qt >= 2 ? 4 * qt - 8 : 0, nt = kt_hi - kt_lo + 1;
    const int cw = 4 * qt + (wid >> 1), q0w = qt * 256 + wid * 32, qpos = q0w + r32;
    const float* tabg = WSP(float, WS_TABA) + (l * 8 + h) * TABA_N;
    LAS float* tabl = (LAS float*)(C.lds + 131072);
    AT_BAR();
    for (int i = wid * 64 + lane; i < TABA_N; i += NTHREADS) tabl[i] = tabg[i];
    bf16x8 qr[8];
    { const bf16_t* qp = proj + (rowb + qpos) * INW + qcol + 8 * hi;
#pragma unroll
      for (int s = 0; s < KS; ++s) qr[s] = *(const bf16x8*)(qp + 16 * s); }
    unsigned lb0, lb1;
    { const int kv = wid >> 2;
      if (kv == 0) { const int rl = lane >> 4, cp = lane & 15; lb0 = (unsigned)(rl * (INW * 2) + ((cp ^ (rl & 7)) * 16)); lb1 = (unsigned)(rl * (INW * 2) + ((cp ^ ((4 + rl) & 7)) * 16)); }
      else { lb0 = (unsigned)(((lane & 31) >> 2) * (INW * 2) + ((lane >> 5) * 32 + (lane & 3) * 8) * 2); lb1 = lb0; } }
    at_stage1(C.lds, projb, kcolB, vcolB, kt_lo, 0, wid, lb0, lb1);
    at_stage1(C.lds, projb, kcolB, vcolB, kt_lo + 1, 1, wid, lb0, lb1);
    f32x16 o[4], ol = {}; float m_run = 0.f; bool first = true;
#pragma unroll
    for (int d0 = 0; d0 < 4; ++d0) o[d0] = f32x16{};
    const bf16x8 ones = {16256, 16256, 16256, 16256, 16256, 16256, 16256, 16256};
    asm volatile("s_waitcnt vmcnt(4) lgkmcnt(0)\n\ts_barrier" ::: "memory");
    const float cfar = tabl[0];
    const int vrd = at_v_rd_base(lane);
    for (int sd = 0; sd < nt; ++sd) {
        const int slot = sd % 3, kt = kt_lo + sd;
        const bool staged = sd + 2 < nt;
        if (staged) at_stage1(C.lds, projb, kcolB, vcolB, kt + 2, (sd + 2) % 3, wid, lb0, lb1);
        if (kt <= cw && kt >= cw - 8) {
            LAS const unsigned char* Kt = C.lds + slot * 32768;
            const int vb = (int)(size_t)(Kt + 16384) + vrd;
            const bool nearb = (kt * 64 + 63 - q0w) > -128;
            LAS const float* tabp = tabl + (kt * 64 - qpos + TABA_OFF + 4 * hi);
            f32x16 p0, p1;
            at_qk<KS>(p0, p1, Kt, 0, qr, (nearb ? 0.f : cfar) - m_run, r32, hi);
            const float alpha = at_softmax(p0, p1, m_run, first, nearb, tabp, lane);
            first = false;
            if (__any(alpha != 1.f)) {
                ol[0] *= alpha;
#pragma unroll
                for (int d0 = 0; d0 < 4; ++d0)
#pragma unroll
                    for (int i = 0; i < 16; ++i) o[d0][i] *= alpha;
            }
            bf16x8 pf[4];
            pf[0] = at_pack(p0, 0); pf[1] = at_pack(p0, 8); pf[2] = at_pack(p1, 0); pf[3] = at_pack(p1, 8);
            ol = MFMA32(ones, pf[0], ol); ol = MFMA32(ones, pf[1], ol); ol = MFMA32(ones, pf[2], ol); ol = MFMA32(ones, pf[3], ol);
            at_pv_block<0>(o, vb, pf); at_pv_block<1>(o, vb, pf); at_pv_block<2>(o, vb, pf); at_pv_block<3>(o, vb, pf);
        }
        if (staged) asm volatile("s_waitcnt vmcnt(4) lgkmcnt(0)\n\ts_barrier" ::: "memory");
        else        asm volatile("s_waitcnt vmcnt(0) lgkmcnt(0)\n\ts_barrier" ::: "memory");
    }
    const float inv = 1.f / ol[0];
    if (l >= L8B) { unsigned pk8v[4][4];
#pragma unroll
        for (int d0 = 0; d0 < 4; ++d0)
#pragma unroll
            for (int gq = 0; gq < 4; ++gq) pk8v[d0][gq] = pk8(clamp8(o[d0][4 * gq] * inv), clamp8(o[d0][4 * gq + 1] * inv), clamp8(o[d0][4 * gq + 2] * inv), clamp8(o[d0][4 * gq + 3] * inv));
        at_store_rows8(pk8v, C.lds + wid * 8704, WSP(unsigned char, WS_MIX) + (rowb + q0w) * D + h * 128, r32, hi, lane);
    } else {
    u32x2 pk[4][4];
#pragma unroll
    for (int d0 = 0; d0 < 4; ++d0)
#pragma unroll
        for (int gq = 0; gq < 4; ++gq) { pk[d0][gq].x = at_cvtpk(o[d0][4 * gq] * inv, o[d0][4 * gq + 1] * inv); pk[d0][gq].y = at_cvtpk(o[d0][4 * gq + 2] * inv, o[d0][4 * gq + 3] * inv); }
    at_store_rows(pk, C.lds + wid * 8704, WSP(bf16_t, WS_MIX) + (rowb + q0w) * D + h * 128, r32, hi, lane); }
}
DI void phase_attn(const Ctx& C, int l) {
    const int G = (int)gridDim.x, cb = (int)blockIdx.x;
    const int vc = (G == 256) ? ((cb & 7) * 32 + (cb >> 3)) : cb;
    for (int pc = vc; pc < 256; pc += G) { const int bh = pc >> 4, jp = pc & 15;
        attn_unit_diff(C, l, bh >> 3, bh & 7, 31 - jp); attn_unit_diff(C, l, bh >> 3, bh & 7, jp); }
    for (int ia = vc; ia < 256; ia += G) { const int bh = ia >> 4; attn_unit_band(C, l, bh >> 3, bh & 7, ia & 15); }
    AT_BAR();
}

namespace pg8 {
constexpr int BM = 256, BK = 64, HALF = 128, HTB = HALF * BK * 2, STAGE_BYTES = 8 * HTB;
__host__ __device__ __forceinline__ int lds_byte(int r, int c) { const int st = (r >> 4) * 2 + (c >> 5), rr = r & 15, cc = c & 31, ob = rr * 64 + cc * 2; return st * 1024 + (ob ^ (((ob >> 9) & 1) << 5)); }
__host__ __device__ __forceinline__ void stage_rc(int b, int& R, int& C) { const int st = b / 1024, sb = b % 1024, swz = sb ^ (((sb >> 9) & 1) << 5); R = (st >> 1) * 16 + swz / 64; C = (st & 1) * 32 + (swz % 64) / 2; }
__host__ __device__ __forceinline__ int perm32(int rho) { const int n = rho >> 4, i = rho & 15; return 8 * (i >> 2) + 4 * n + (i & 3); }
struct Unit { const char* A; const char* B; int pm, pn, z, n, base; };
__device__ __forceinline__ unsigned cvt_pk_bf16(float lo, float hi) { unsigned r; asm volatile("v_cvt_pk_bf16_f32 %0, %1, %2" : "=v"(r) : "v"(lo), "v"(hi)); return r; }

template <class Epi, class Sched, bool ALIGN_EPI, bool GATHER = false, bool F8 = false>
__device__ __forceinline__ void gemm_phase(LAS unsigned char* lds, const int tid, const int lda, const int ldb, const int K, const Sched& S, const Epi& E) {
    const int wid = __builtin_amdgcn_readfirstlane(tid >> 6), lane = tid & 63, wr = wid >> 2, wc = wid & 3, fr = lane & 15, fq = lane >> 4;
    const int nt = K / BK;
    unsigned voffA[2], voffB[2];
#pragma unroll
    for (int i = 0; i < 2; ++i) { int R, C; stage_rc(tid * 16 + i * 8192, R, C); const int Rb = (R & ~31) + perm32(R & 31);
        voffA[i] = (unsigned)(R * lda + C) * 2u; voffB[i] = (unsigned)(Rb * ldb + C) * 2u; }
    const size_t kstep = (size_t)(BK * 2);
    const size_t hstepA = GATHER ? (size_t)0 : (size_t)HALF * lda * 2, hstepB = (size_t)HALF * ldb * 2;
    unsigned cvo[2][2];
    const unsigned ldsw = (unsigned)wid * 1024u;
    const int aoff = lds_byte(wr * 64 + fr, fq * 8), boff = lds_byte(wc * 32 + fr, fq * 8);
#define PG8_SA(b, h) (((b) * 2 + (h)) * HTB)
#define PG8_SB(b, h) ((4 + (b) * 2 + (h)) * HTB)
#define PG8_STAGE(bufoff, gbase, voff) do { _Pragma("unroll") for (int _i = 0; _i < 2; ++_i) \
        __builtin_amdgcn_global_load_lds((const unsigned*)((const char*)(gbase) + (voff)[_i]), (LAS unsigned*)(lds + (bufoff) + ldsw + _i * 8192), 16, 0, 0); } while (0)
#define PG8_STAGE_A(bufoff, gbase, hh, vo) do { if constexpr (GATHER) { PG8_STAGE(bufoff, gbase, (vo)[hh]); } else { PG8_STAGE(bufoff, (gbase) + (hh) * hstepA, voffA); } } while (0)
#define PG8_GOFFS(u, vo) do { if constexpr (GATHER) { const int* _ix = S.idx(u); _Pragma("unroll") for (int _h = 0; _h < 2; ++_h) _Pragma("unroll") for (int _i = 0; _i < 2; ++_i) { int _gR, _gC; stage_rc(tid * 16 + _i * 8192, _gR, _gC); const int _r = (u).pm * BM + _h * HALF + _gR; \
        const int _tk = _ix[_r < (u).n ? _r : 0] >> 1; const int _tok = _r < (u).n ? _tk : 0; (vo)[_h][_i] = (unsigned)(_tok * lda + _gC) * 2u; } } } while (0)
#define PG8_LD8(p) __builtin_shufflevector(*(const LAS i32x4*)(p), *(const LAS i32x4*)((p) + 1024), 0, 1, 2, 3, 4, 5, 6, 7)
#define PG8_LDA(dst, b, h) do { if constexpr (F8) { _Pragma("unroll") for (int m = 0; m < 4; ++m) dst##8[m] = PG8_LD8(lds + PG8_SA(b, h) + aoff + m * 2048); } \
      else { _Pragma("unroll") for (int m = 0; m < 4; ++m) _Pragma("unroll") for (int k = 0; k < 2; ++k) dst[m][k] = *(const LAS bf16x8*)(lds + PG8_SA(b, h) + aoff + m * 2048 + k * 1024); } } while (0)
#define PG8_LDB(dst, b, h) do { if constexpr (F8) { _Pragma("unroll") for (int n = 0; n < 2; ++n) dst##8[n] = PG8_LD8(lds + PG8_SB(b, h) + boff + n * 2048); } \
      else { _Pragma("unroll") for (int n = 0; n < 2; ++n) _Pragma("unroll") for (int k = 0; k < 2; ++k) dst[n][k] = *(const LAS bf16x8*)(lds + PG8_SB(b, h) + boff + n * 2048 + k * 1024); } } while (0)
#define PG8_MMA(ai, bj, At, Bt) do { __builtin_amdgcn_s_setprio(1); if constexpr (F8) { _Pragma("unroll") for (int m = 0; m < 4; ++m) _Pragma("unroll") for (int n = 0; n < 2; ++n) \
        asm volatile("v_mfma_f32_16x16x128_f8f6f4 %0, %1, %2, %0" : "+v"(acc[ai][bj][m][n]) : "v"(Bt##8[n]), "v"(At##8[m])); } \
      else { _Pragma("unroll") for (int m = 0; m < 4; ++m) _Pragma("unroll") for (int n = 0; n < 2; ++n) _Pragma("unroll") for (int k = 0; k < 2; ++k) \
        acc[ai][bj][m][n] = __builtin_amdgcn_mfma_f32_16x16x32_bf16(Bt[n][k], At[m][k], acc[ai][bj][m][n], 0, 0, 0); } __builtin_amdgcn_s_setprio(0); } while (0)
#define PG8_WAIT_V(n) asm volatile("s_waitcnt vmcnt(" #n ")" ::: "memory")
#define PG8_WAIT_L(n) asm volatile("s_waitcnt lgkmcnt(" #n ")" ::: "memory")
#define PG8_BAR __builtin_amdgcn_s_barrier()
#define PG8_SCHED __builtin_amdgcn_sched_barrier(0)
    Unit cur, nxt; int ui = 0;
    if (!S.next(0, cur)) return;
    f32x4 acc[2][2][4][2];
    u32x4 oldv[2][4][2];
    if constexpr (Epi::HAS_INIT) { E.init_load(oldv, cur, wr, wc, fr, fq); __builtin_amdgcn_sched_barrier(0); }
    else {
#pragma unroll
    for (int a = 0; a < 2; ++a)
#pragma unroll
        for (int b = 0; b < 2; ++b)
#pragma unroll
            for (int m = 0; m < 4; ++m)
#pragma unroll
                for (int n = 0; n < 2; ++n) acc[a][b][m][n] = (f32x4){0.f, 0.f, 0.f, 0.f};
    }
    bf16x8 At[4][2], B0[2][2], B1[2][2]; i32x8 At8[4], B08[2], B18[2];
    const char* cA = cur.A; const char* cB = cur.B;
    PG8_GOFFS(cur, cvo);
    PG8_STAGE(PG8_SB(0, 0), cB, voffB); PG8_STAGE(PG8_SB(0, 1), cB + hstepB, voffB); PG8_STAGE_A(PG8_SA(0, 0), cA, 0, cvo); PG8_STAGE_A(PG8_SA(0, 1), cA, 1, cvo);
    if (wr == 1) PG8_BAR;
    PG8_WAIT_V(2); PG8_BAR;
    if constexpr (Epi::HAS_INIT) { E.init_finish(acc, oldv); __builtin_amdgcn_sched_barrier(0); }
    PG8_STAGE(PG8_SB(1, 0), cB + kstep, voffB); PG8_STAGE_A(PG8_SA(1, 0), cA + kstep, 0, cvo); PG8_STAGE(PG8_SB(1, 1), cB + hstepB + kstep, voffB);
    PG8_WAIT_V(6); PG8_BAR;
    for (;;) {
        const bool has_next = S.next(ui + 1, nxt);
        const char* nA = has_next ? nxt.A : cA; const char* nB = has_next ? nxt.B : cB;
#pragma nounroll
        for (int t = 0; t < nt; t += 2) {
            const bool last = (t == nt - 2);
            if constexpr (GATHER) asm volatile("" : "+v"(cvo[0][0]), "+v"(cvo[0][1]), "+v"(cvo[1][0]), "+v"(cvo[1][1]));
            asm volatile("" : "+v"(voffA[0]), "+v"(voffA[1]), "+v"(voffB[0]), "+v"(voffB[1]));
            const char* a1 = cA + (size_t)(t + 1) * kstep;
            const char* a2 = last ? nA : cA + (size_t)(t + 2) * kstep; const char* b2 = last ? nB : cB + (size_t)(t + 2) * kstep;
            const char* a3 = a2 + kstep; const char* b3 = b2 + kstep;
            PG8_LDB(B0, 0, 0); PG8_LDB(B1, 0, 1); PG8_SCHED; PG8_LDA(At, 0, 0); PG8_STAGE_A(PG8_SA(1, 1), a1, 1, cvo);
            if constexpr (GATHER) { if (last && has_next) { PG8_GOFFS(nxt, cvo); } }
            PG8_WAIT_V(8); PG8_WAIT_L(0); PG8_BAR; PG8_MMA(0, 0, At, B0); PG8_MMA(0, 1, At, B1); PG8_BAR; PG8_SCHED;
            PG8_LDA(At, 0, 1); PG8_STAGE(PG8_SB(0, 0), b2, voffB); PG8_STAGE(PG8_SB(0, 1), b2 + hstepB, voffB); PG8_STAGE_A(PG8_SA(0, 0), a2, 0, cvo);
            PG8_WAIT_V(8); PG8_WAIT_L(0); PG8_BAR; PG8_MMA(1, 0, At, B0); PG8_MMA(1, 1, At, B1); PG8_BAR; PG8_SCHED;
            PG8_LDB(B0, 1, 0); PG8_LDB(B1, 1, 1); PG8_SCHED; PG8_LDA(At, 1, 0); PG8_STAGE_A(PG8_SA(0, 1), a2, 1, cvo);
            PG8_WAIT_V(8); PG8_WAIT_L(0); PG8_BAR; PG8_MMA(0, 0, At, B0); PG8_MMA(0, 1, At, B1); PG8_BAR; PG8_SCHED;
            PG8_LDA(At, 1, 1); PG8_STAGE(PG8_SB(1, 0), b3, voffB); PG8_STAGE(PG8_SB(1, 1), b3 + hstepB, voffB); PG8_STAGE_A(PG8_SA(1, 0), a3, 0, cvo);
            PG8_WAIT_V(8); PG8_WAIT_L(0); PG8_BAR; PG8_MMA(1, 0, At, B0); PG8_MMA(1, 1, At, B1); PG8_BAR; PG8_SCHED;
        }
        if constexpr (ALIGN_EPI) { if (wr == 0) PG8_BAR; }
        if constexpr (F8) asm volatile("s_nop 15\n\ts_nop 15" ::: "memory");
        if constexpr (!Epi::AFTER_DRAIN) { unsigned z_ = 0u; asm volatile("" : "+s"(z_)); const int l_ = (int)__builtin_amdgcn_mbcnt_hi(~0u, __builtin_amdgcn_mbcnt_lo(~0u, z_));
            E(acc, cur, wr, wc, l_ & 15, l_ >> 4); }
        if (!has_next) break;
        if constexpr (Epi::HAS_INIT) { unsigned z2_ = 0u; asm volatile("" : "+s"(z2_)); const int l2_ = (int)__builtin_amdgcn_mbcnt_hi(~0u, __builtin_amdgcn_mbcnt_lo(~0u, z2_)); E.init(acc, nxt, wr, wc, l2_ & 15, l2_ >> 4); }
        else {
#pragma unroll
        for (int a = 0; a < 2; ++a)
#pragma unroll
            for (int b = 0; b < 2; ++b)
#pragma unroll
                for (int m = 0; m < 4; ++m)
#pragma unroll
                    for (int n = 0; n < 2; ++n) acc[a][b][m][n] = (f32x4){0.f, 0.f, 0.f, 0.f};
        }
        cur = nxt; cA = nA; cB = nB; ++ui;
        if constexpr (ALIGN_EPI) { if (wr == 1) PG8_BAR; }
    }
    PG8_WAIT_V(0);
    if constexpr (!ALIGN_EPI) { if (wr == 0) PG8_BAR; }
    PG8_BAR;
    if constexpr (F8 && Epi::AFTER_DRAIN) asm volatile("s_nop 15\n\ts_nop 15" ::: "memory");
    if constexpr (Epi::AFTER_DRAIN) { unsigned z_ = 0u; asm volatile("" : "+s"(z_)); const int l_ = (int)__builtin_amdgcn_mbcnt_hi(~0u, __builtin_amdgcn_mbcnt_lo(~0u, z_));
        E.fused(acc, cur, wr, wc, l_ & 15, l_ >> 4, lds, wid, l_); }
#undef PG8_SA
#undef PG8_SB
#undef PG8_STAGE
#undef PG8_STAGE_A
#undef PG8_GOFFS
#undef PG8_LDA
#undef PG8_LDB
#undef PG8_MMA
#undef PG8_LD8
#undef PG8_WAIT_V
#undef PG8_WAIT_L
#undef PG8_BAR
#undef PG8_SCHED
}

struct DenseOrder {
    const char* A; const char* B; int lda, ldb, nM, nN, nwg, G, c;
    __device__ __forceinline__ void init(const void* A_, const void* B_, int lda_, int ldb_, int M, int N, int G_, int c_) { A = (const char*)A_; B = (const char*)B_; lda = lda_; ldb = ldb_; nM = M / BM; nN = N / BM; nwg = nM * nN; G = G_; c = c_; }
    __device__ __forceinline__ bool next(int i, Unit& u) const {
        const long L = (long)i * G + c; if (L >= nwg) return false;
        int wgid = (int)L; { const int q = nwg / 8, r = nwg % 8, xcd = wgid % 8, off = wgid / 8; wgid = (xcd < r ? xcd * (q + 1) : r * (q + 1) + (xcd - r) * q) + off; }
        const int nig = 8 * nN, gid = wgid / nig, fm = gid * 8, gsz = (nM - fm) < 8 ? (nM - fm) : 8;
        u.pm = fm + ((wgid % nig) % gsz); u.pn = (wgid % nig) / gsz; u.z = 0; u.n = 0; u.base = 0;
        u.A = A + (size_t)u.pm * BM * lda * 2; u.B = B + (size_t)u.pn * BM * ldb * 2; return true;
    }
};
struct MaskOrder {
    const char* A; const char* B; int lda, ldb, nM, nN, nwg, G, c; unsigned mask;
    __device__ __forceinline__ void init(const void* A_, const void* B_, int lda_, int ldb_, int M, unsigned mask_, int G_, int c_) { A = (const char*)A_; B = (const char*)B_; lda = lda_; ldb = ldb_; nM = M / BM; mask = mask_; nN = __builtin_popcount(mask_); nwg = nM * nN; G = G_; c = c_; }
    __device__ __forceinline__ bool next(int i, Unit& u) const {
        const long L = (long)i * G + c; if (L >= nwg) return false;
        int wgid = (int)L; { const int q = nwg / 8, r = nwg % 8, xcd = wgid % 8, off = wgid / 8; wgid = (xcd < r ? xcd * (q + 1) : r * (q + 1) + (xcd - r) * q) + off; }
        const int nig = 8 * nN, gid = wgid / nig, fm = gid * 8, gsz = (nM - fm) < 8 ? (nM - fm) : 8;
        u.pm = fm + ((wgid % nig) % gsz); int k = (wgid % nig) / gsz, pn = 0;
        for (int b = 0; b < 32; ++b) if ((mask >> b) & 1u) { if (k == 0) { pn = b; break; } --k; }
        u.pn = pn; u.z = 0; u.n = 0; u.base = 0;
        u.A = A + (size_t)u.pm * BM * lda * 2; u.B = B + (size_t)u.pn * BM * ldb * 2; return true;
    }
};
struct MultiOrder {
    const char* A; const char* B; size_t a1, a2, a3, b1, b2, b3; int zs, zm, zs3, nM, nN, nz, lda, ldb, G, c;
    __device__ __forceinline__ bool next(int i, Unit& u) const {
        const long L = (long)i * G + c; const int per = nM * nN; if (L >= (long)per * nz) return false;
        const int z = (int)(L / per), r = (int)(L % per);
        u.pm = r / nN; u.pn = r % nN; u.z = z; u.n = 0; u.base = 0;
        u.A = A + (size_t)(z >> zs) * a1 + (size_t)(z & zm) * a2 + (size_t)(z >> zs3) * a3 + (size_t)u.pm * BM * lda * 2;
        u.B = B + (size_t)(z >> zs) * b1 + (size_t)(z & zm) * b2 + (size_t)(z >> zs3) * b3 + (size_t)u.pn * BM * ldb * 2; return true;
    }
};

__device__ __forceinline__ void rowscale4(const float* part, size_t rowb, int fq, int lane, float (&sc)[4]) {
    f32x4 a[4], b[4];
#pragma unroll
    for (int m = 0; m < 4; ++m) { const f32x4* p = (const f32x4*)(part + (rowb + 16 * m) * 32 + fq * 8); a[m] = p[0]; b[m] = p[1]; }
#pragma unroll
    for (int m = 0; m < 4; ++m) { float s = ((a[m].x + a[m].y) + (a[m].z + a[m].w)) + ((b[m].x + b[m].y) + (b[m].z + b[m].w));
        s = sum_x32(sum_x16(s, lane), lane); sc[m] = rsqrtf(s * (1.f / D) + EPS); }
}
template <int SC, bool INP8 = false, bool V8 = false> struct EpiStore {
    static constexpr bool AFTER_DRAIN = false; static constexpr bool HAS_INIT = false;
    bf16_t* O; size_t o1, o2; int zs, zm, ldc; const float* rv; size_t rvz;
    float s8;
    __device__ __forceinline__ void operator()(const f32x4 (&acc)[2][2][4][2], const Unit& u, int wr, int wc, int fr, int fq) const {
        const int row0 = u.pm * BM + wr * 64 + fr, col0 = u.pn * BM + wc * 32 + 8 * fq;
        bf16_t* base = O + (size_t)(u.z >> zs) * o1 + (size_t)(u.z & zm) * o2;
#pragma unroll
        for (int ai = 0; ai < 2; ++ai) {
            float sc[4] = {1.f, 1.f, 1.f, 1.f};
            if (SC == 1) rowscale4(rv, (size_t)u.z * rvz + row0 + ai * HALF, fq, fr + 16 * fq, sc);
            if constexpr (INP8) { const float cs = (u.pn < 4 ? SC_A : ((u.pn >= 12 && u.pn < 16) ? SC_B : 1.f)) * (1.f / W8S);
#pragma unroll
                for (int m = 0; m < 4; ++m) sc[m] *= cs; }
            if (SC == 2) {
#pragma unroll
                for (int m = 0; m < 4; ++m) sc[m] = rv[(size_t)u.z * rvz + row0 + ai * HALF + m * 16]; }
#pragma unroll
            for (int m = 0; m < 4; ++m) { const int row = row0 + ai * HALF + m * 16;
                bf16_t* rowp = base + (size_t)row * ldc + col0;
                if constexpr (V8) { { unsigned char* rp8 = (unsigned char*)O + (size_t)(u.z >> zs) * o1 + (size_t)(u.z & zm) * o2 + (size_t)row * ldc + col0; const float s8m = sc[m] * s8;
#pragma unroll
                    for (int bj = 0; bj < 2; ++bj) { const f32x4 v0 = acc[ai][bj][m][0] * s8m, v1 = acc[ai][bj][m][1] * s8m;
                        u32x2 w8; w8.x = pk8(clamp8(v0[0]), clamp8(v0[1]), clamp8(v0[2]), clamp8(v0[3])); w8.y = pk8(clamp8(v1[0]), clamp8(v1[1]), clamp8(v1[2]), clamp8(v1[3]));
                        *(u32x2*)(rp8 + bj * HALF) = w8; }
                    continue; } }
#pragma unroll
                for (int bj = 0; bj < 2; ++bj) { const f32x4 v0 = acc[ai][bj][m][0] * sc[m], v1 = acc[ai][bj][m][1] * sc[m];
                    u32x4 w; w.x = cvt_pk_bf16(v0[0], v0[1]); w.y = cvt_pk_bf16(v0[2], v0[3]); w.z = cvt_pk_bf16(v1[0], v1[1]); w.w = cvt_pk_bf16(v1[2], v1[3]);
                    *(u32x4*)(rowp + bj * HALF) = w; } } }
    }
};
struct EpiResidualPart {
    static constexpr bool AFTER_DRAIN = false; static constexpr bool HAS_INIT = true;
    bf16_t* X; float* part; size_t zrows;
    unsigned char* x8;
    float as;
    __device__ __forceinline__ void init_load(u32x4 (&old)[2][4][2], const Unit& u, int wr, int wc, int fr, int fq) const {
        const int row0 = u.pm * BM + wr * 64 + fr, col0 = u.pn * BM + wc * 32 + 8 * fq;
#pragma unroll
        for (int ai = 0; ai < 2; ++ai)
#pragma unroll
            for (int m = 0; m < 4; ++m)
#pragma unroll
                for (int bj = 0; bj < 2; ++bj) old[ai][m][bj] = *(const u32x4*)(X + ((size_t)u.z * zrows + row0 + ai * HALF + m * 16) * D + col0 + bj * HALF);
    }
    __device__ __forceinline__ void init_finish(f32x4 (&acc)[2][2][4][2], const u32x4 (&old)[2][4][2]) const {
        const float ias = 1.f / as;
#pragma unroll
        for (int ai = 0; ai < 2; ++ai)
#pragma unroll
            for (int m = 0; m < 4; ++m)
#pragma unroll
                for (int bj = 0; bj < 2; ++bj)
#pragma unroll
                    for (int q = 0; q < 4; ++q) { acc[ai][bj][m][q >> 1][(q & 1) * 2] = __uint_as_float(old[ai][m][bj][q] << 16) * ias; acc[ai][bj][m][q >> 1][(q & 1) * 2 + 1] = __uint_as_float(old[ai][m][bj][q] & 0xffff0000u) * ias; }
    }
    __device__ __forceinline__ void init(f32x4 (&acc)[2][2][4][2], const Unit& u, int wr, int wc, int fr, int fq) const { u32x4 old[2][4][2]; init_load(old, u, wr, wc, fr, fq); init_finish(acc, old); }
    __device__ __forceinline__ void operator()(const f32x4 (&acc)[2][2][4][2], const Unit& u, int wr, int wc, int fr, int fq) const {
        const int row0 = u.pm * BM + wr * 64 + fr, col0 = u.pn * BM + wc * 32 + 8 * fq, lane = fr + 16 * fq;
#pragma unroll
        for (int ai = 0; ai < 2; ++ai) {
#pragma unroll
            for (int m = 0; m < 4; ++m) { const size_t row = (size_t)u.z * zrows + row0 + ai * HALF + m * 16;
                bf16_t* rowp = X + row * D + col0; float ss = 0.f;
#pragma unroll
                for (int bj = 0; bj < 2; ++bj) { u32x4 w;
#pragma unroll
                    for (int q = 0; q < 4; ++q) { const float lo = acc[ai][bj][m][q >> 1][(q & 1) * 2] * as, hi = acc[ai][bj][m][q >> 1][(q & 1) * 2 + 1] * as;
                        w[q] = cvt_pk_bf16(lo, hi); const float a = __uint_as_float(w[q] << 16), b = __uint_as_float(w[q] & 0xffff0000u); ss += a * a + b * b; }
                    *(u32x4*)(rowp + bj * HALF) = w;
                    if (x8) { u32x2 e;
#pragma unroll
                        for (int h2 = 0; h2 < 2; ++h2) e[h2] = pk8(clamp8(__uint_as_float(w[2 * h2] << 16)), clamp8(__uint_as_float(w[2 * h2] & 0xffff0000u)), clamp8(__uint_as_float(w[2 * h2 + 1] << 16)), clamp8(__uint_as_float(w[2 * h2 + 1] & 0xffff0000u)));
                        *(u32x2*)(x8 + row * D + col0 + bj * HALF) = e; } }
                ss = sum_x32(sum_x16(ss, lane), lane);
                if (fq == 0) part[row * 32 + u.pn * 4 + wc] = ss; } }
    }
};
struct EpiSoftmaxP {
    static constexpr bool AFTER_DRAIN = true; static constexpr bool HAS_INIT = false;
    bf16_t* P; const float* part; int f8; float as;
    __device__ __forceinline__ void fused(f32x4 (&acc)[2][2][4][2], const Unit& u, int wr, int wc, int fr, int fq, LAS unsigned char* lds, int wid, int lane) const {
        LAS float* MX = (LAS float*)lds; LAS float* SM = (LAS float*)(lds + 4096);
        const int row0 = u.pm * BM + wr * 64 + fr, col0 = u.pn * BM + wc * 32 + 8 * fq;
#pragma unroll
        for (int ai = 0; ai < 2; ++ai) {
            float scv[4]; rowscale4(part, (size_t)u.z * SEQ + row0 + ai * HALF, fq, lane, scv);
#pragma unroll
            for (int m = 0; m < 4; ++m) { const float sc = scv[m] * as; float mx = -3.0e38f;
#pragma unroll
                for (int bj = 0; bj < 2; ++bj)
#pragma unroll
                    for (int n = 0; n < 2; ++n) { acc[ai][bj][m][n] = acc[ai][bj][m][n] * sc; const f32x4 v = acc[ai][bj][m][n]; mx = fmaxf(mx, fmaxf(fmaxf(v[0], v[1]), fmaxf(v[2], v[3]))); }
                mx = max_x32(max_x16(mx, lane), lane);
                if (fq == 0) MX[(ai * HALF + wr * 64 + m * 16 + fr) * 4 + wc] = mx; } }
        asm volatile("s_waitcnt lgkmcnt(0)" ::: "memory"); __builtin_amdgcn_s_barrier(); asm volatile("" ::: "memory");
#pragma unroll
        for (int ai = 0; ai < 2; ++ai)
#pragma unroll
            for (int m = 0; m < 4; ++m) { const int R = ai * HALF + wr * 64 + m * 16 + fr; const f32x4 mv = *(const LAS f32x4*)(MX + R * 4);
                const float gm = fmaxf(fmaxf(mv[0], mv[1]), fmaxf(mv[2], mv[3])); float s = 0.f;
#pragma unroll
                for (int bj = 0; bj < 2; ++bj)
#pragma unroll
                    for (int n = 0; n < 2; ++n) { f32x4 v = acc[ai][bj][m][n];
#pragma unroll
                        for (int q = 0; q < 4; ++q) { v[q] = __builtin_amdgcn_exp2f(v[q] - gm); s += v[q]; }
                        acc[ai][bj][m][n] = v; }
                s = sum_x32(sum_x16(s, lane), lane);
                if (fq == 0) SM[R * 4 + wc] = s; }
        asm volatile("s_waitcnt lgkmcnt(0)" ::: "memory"); __builtin_amdgcn_s_barrier(); asm volatile("" ::: "memory");
#pragma unroll
        for (int ai = 0; ai < 2; ++ai)
#pragma unroll
            for (int m = 0; m < 4; ++m) { const int R = ai * HALF + wr * 64 + m * 16 + fr; const f32x4 sv = *(const LAS f32x4*)(SM + R * 4);
                const float inv = 1.f / ((sv[0] + sv[1]) + (sv[2] + sv[3]));
                bf16_t* rowp = P + ((size_t)u.z * SEQ + row0 + ai * HALF + m * 16) * 1024 + col0;
                if (f8) { unsigned char* rowp8 = (unsigned char*)P + ((size_t)u.z * SEQ + row0 + ai * HALF + m * 16) * 1024 + col0; const float i8 = inv * P8S;
#pragma unroll
                    for (int bj = 0; bj < 2; ++bj) { const f32x4 v0 = acc[ai][bj][m][0] * i8, v1 = acc[ai][bj][m][1] * i8;
                        u32x2 w8; w8.x = pk8(v0[0], v0[1], v0[2], v0[3]); w8.y = pk8(v1[0], v1[1], v1[2], v1[3]);
                        *(u32x2*)(rowp8 + bj * HALF) = w8; } }
                else {
#pragma unroll
                for (int bj = 0; bj < 2; ++bj) { const f32x4 v0 = acc[ai][bj][m][0] * inv, v1 = acc[ai][bj][m][1] * inv;
                    u32x4 w; w.x = cvt_pk_bf16(v0[0], v0[1]); w.y = cvt_pk_bf16(v0[2], v0[3]); w.z = cvt_pk_bf16(v1[0], v1[1]); w.w = cvt_pk_bf16(v1[2], v1[3]);
                    *(u32x4*)(rowp + bj * HALF) = w; } } }
        asm volatile("s_waitcnt lgkmcnt(0)" ::: "memory"); __builtin_amdgcn_s_barrier(); asm volatile("" ::: "memory");
    }
};
template <int NTN, bool UP> struct MoeOrder {
    int cv;
    const int* ltok; const char* A; const char* B; size_t bstride; int lda, ldb, G, c;
    __device__ __forceinline__ const int* idx(const Unit& u) const { return ltok + (size_t)u.z * T; }
    __device__ __forceinline__ bool next(int i, Unit& u) const {
        const long L = (long)i * G + c; long accu = 0; int base = 0;
        for (int e = 0; e < NE; ++e) { const int n = __builtin_amdgcn_readlane(cv, e); const int nt = ((n + 255) >> 8) * NTN;
            if (L < accu + nt) { const int r = (int)(L - accu); u.pm = r / NTN; u.pn = r % NTN; u.z = e; u.n = n; u.base = base;
                u.A = UP ? A : A + (size_t)(base + u.pm * BM) * lda * 2; u.B = B + (size_t)e * bstride + (size_t)u.pn * BM * ldb * 2; return true; }
            accu += nt; base += (n + 255) & ~255; }
        return false;
    }
};
template <bool F8 = false> struct EpiMoeUpF {
    static constexpr bool AFTER_DRAIN = false; static constexpr bool HAS_INIT = false;
    bf16_t* hid; const float* lw; const float* lr;
    __device__ __forceinline__ void operator()(const f32x4 (&acc)[2][2][4][2], const Unit& u, int wr, int wc, int fr, int fq) const {
        const int r0 = u.pm * BM + wr * 64 + fr, f0 = u.pn * 128 + wc * 32 + 8 * fq;
        float rsv[2][4], wv[2][4];
#pragma unroll
        for (int ai = 0; ai < 2; ++ai)
#pragma unroll
            for (int m = 0; m < 4; ++m) { const int r = r0 + ai * HALF + m * 16; rsv[ai][m] = lr[(size_t)u.z * T + r]; wv[ai][m] = lw[(size_t)u.z * T + r]; }
#pragma unroll
        for (int ai = 0; ai < 2; ++ai)
#pragma unroll
            for (int m = 0; m < 4; ++m) { const int r = r0 + ai * HALF + m * 16;
                if (r < u.n) { const float rs = rsv[ai][m] * (F8 ? 1.f / W8S : 1.f), w = wv[ai][m] * (F8 ? H8S : 1.f); float hv[8];
#pragma unroll
                    for (int q = 0; q < 8; ++q) { const float a = acc[ai][0][m][q >> 2][q & 3] * rs, b = acc[ai][1][m][q >> 2][q & 3] * rs;
                        hv[q] = a * __builtin_amdgcn_rcpf(1.f + __builtin_amdgcn_exp2f(-a * LOG2E)) * b * w; }
                    if constexpr (F8) { u32x2 o8; o8.x = pk8(clamp8(hv[0]), clamp8(hv[1]), clamp8(hv[2]), clamp8(hv[3])); o8.y = pk8(clamp8(hv[4]), clamp8(hv[5]), clamp8(hv[6]), clamp8(hv[7]));
                        *(u32x2*)((unsigned char*)hid + (size_t)(u.base + r) * DE + f0) = o8; }
                    else { u32x4 o; o.x = cvt_pk_bf16(hv[0], hv[1]); o.y = cvt_pk_bf16(hv[2], hv[3]); o.z = cvt_pk_bf16(hv[4], hv[5]); o.w = cvt_pk_bf16(hv[6], hv[7]);
                        *(u32x4*)(hid + (size_t)(u.base + r) * DE + f0) = o; } } }
    }
};
template <bool F8 = false> struct EpiMoeDownF {
    static constexpr bool AFTER_DRAIN = false; static constexpr bool HAS_INIT = false;
    bf16_t* Y; const int* ltok;
    __device__ __forceinline__ void operator()(const f32x4 (&acc)[2][2][4][2], const Unit& u, int wr, int wc, int fr, int fq) const {
        const int r0 = u.pm * BM + wr * 64 + fr, col0 = u.pn * BM + wc * 32 + 8 * fq;
        int ev[2][4];
#pragma unroll
        for (int ai = 0; ai < 2; ++ai)
#pragma unroll
            for (int m = 0; m < 4; ++m) ev[ai][m] = ltok[(size_t)u.z * T + r0 + ai * HALF + m * 16];
#pragma unroll
        for (int ai = 0; ai < 2; ++ai)
#pragma unroll
            for (int m = 0; m < 4; ++m) { const int r = r0 + ai * HALF + m * 16;
                if (r < u.n) { const int e = ev[ai][m]; bf16_t* rowp = Y + ((size_t)(e & 1) * T + (e >> 1)) * D + col0;
#pragma unroll
                    for (int bj = 0; bj < 2; ++bj) { constexpr float ds = F8 ? Y8S / (W8S * H8S) : 1.f; const f32x4 v0 = acc[ai][bj][m][0] * ds, v1 = acc[ai][bj][m][1] * ds;
                        if constexpr (F8) { u32x2 w8; w8.x = pk8(clamp8(v0[0]), clamp8(v0[1]), clamp8(v0[2]), clamp8(v0[3])); w8.y = pk8(clamp8(v1[0]), clamp8(v1[1]), clamp8(v1[2]), clamp8(v1[3]));
                            *(u32x2*)((unsigned char*)Y + ((size_t)(e & 1) * T + (e >> 1)) * D + col0 + bj * HALF) = w8; }
                        else { u32x4 w; w.x = cvt_pk_bf16(v0[0], v0[1]); w.y = cvt_pk_bf16(v0[2], v0[3]); w.z = cvt_pk_bf16(v1[0], v1[1]); w.w = cvt_pk_bf16(v1[2], v1[3]);
                            *(u32x4*)(rowp + bj * HALF) = w; } } } }
    }
};
}

constexpr int NPRO = 3, NPL = 9, NPH = NPRO + NL * NPL;
#ifndef Q_X1
#define Q_X1 8
#endif
#ifndef Q_UP
#define Q_UP 8
#endif

__global__ void __launch_bounds__(NTHREADS, 2) mk_fwd(Args args) {
    extern __shared__ __attribute__((aligned(16))) unsigned char lds_raw[];
    Ctx C;
    C.ka = (const __attribute__((address_space(4))) unsigned char*)__builtin_amdgcn_kernarg_segment_ptr();
    C.out = args.out; C.ws = (GAS unsigned char*)args.ws;
    C.lds = (LAS unsigned char*)lds_raw;
    C.tid = threadIdx.x; C.lane = C.tid & 63; C.wave = __builtin_amdgcn_readfirstlane(C.tid >> 6);
    C.gw = blockIdx.x * NWAVES + C.wave; C.ngw = gridDim.x * NWAVES;
    volatile LAS unsigned* MISC = (volatile LAS unsigned*)(C.lds + LDS_MISC);
    if (C.tid < 32) MISC[C.tid] = 0u;
    __syncthreads();
    XcdBarrier bar = xcd_barrier_post(WSP(unsigned, WS_CTL) + CW_BAR, MISC + 8);
    const int lo = args.ph_lo, hi = args.ph_hi;
    const int G = (int)gridDim.x, cb = (int)blockIdx.x;
#define XCD_C(tot) ((G >= (tot)) ? ((cb < (tot)) ? ((cb & 7) * ((tot) >> 3) + (cb >> 3)) : (tot)) : cb)
#define XCD_G(tot) ((G >= (tot)) ? (1 << 20) : G)
    int p = 0;
#define PH_BEGIN if (p >= lo && p < hi) { { unsigned z0_ = 0u; asm volatile("" : "+s"(C.ws), "+s"(z0_), "+s"(C.ka));     \
        C.lane = (int)__builtin_amdgcn_mbcnt_hi(~0u, __builtin_amdgcn_mbcnt_lo(~0u, z0_)); C.tid = C.wave * 64 + C.lane; }
#define PH_END   if (p + 1 < hi) xcd_barrier(bar, C.tid); else __syncthreads(); } ++p;

    PH_BEGIN phase_prologue(C); PH_END
    PH_BEGIN
        pg8::MultiOrder S{(const char*)WSP(unsigned char, WS_MEMB), (const char*)WSP(unsigned char, WS_WKV), 0, 0, 0, (size_t)4096 * D, 0, 0, 0, 0, 0, 2, 16, NL, D / 2, D / 2, XCD_G(128), XCD_C(128)};
        pg8::EpiStore<2, false, true> E{WSP(bf16_t, WS_KVB), (size_t)MT * 4096, 0, 0, 0, 4096, WSP(float, WS_RMEM), 0, 1.f / W8S};
        pg8::gemm_phase<pg8::EpiStore<2, false, true>, pg8::MultiOrder, true, false, true>(C.lds, C.tid, D / 2, D / 2, D / 2, S, E);
    PH_END
    PH_BEGIN
        { pg8::MultiOrder S{(const char*)WSP(unsigned char, WS_KVB), (const char*)WSP(unsigned char, WS_WQS), (size_t)MEM * 4096, 512, 0, 0, 512, (size_t)D * D, 2, 3, 3, 1, 8, NL * NB * 4, 2048, D / 2, XCD_G(256), XCD_C(256)};
          pg8::EpiStore<0, false, true> E{WSP(bf16_t, WS_WQK), (size_t)1024 * D, (size_t)256 * D, 2, 3, D, nullptr, 0, V8S / Q8S};
          pg8::gemm_phase<pg8::EpiStore<0, false, true>, pg8::MultiOrder, false, false, true>(C.lds, C.tid, 2048, D / 2, 256, S, E); }
        { pg8::MultiOrder S{(const char*)WSP(unsigned char, WS_WXO), (const char*)(WSP(unsigned char, WS_KVB) + 2048), 0, 512, (size_t)D * D, (size_t)MEM * 4096, 512, 0, 2, 3, 3, 8, 1, NL * NB * 4, D / 2, 2048, XCD_G(256), XCD_C(256)};
          pg8::EpiStore<0, false, true> E{WSP(bf16_t, WS_VOT), (size_t)D * 1024, 256, 2, 3, 1024, nullptr, 0, V8S / W8S};
          pg8::gemm_phase<pg8::EpiStore<0, false, true>, pg8::MultiOrder, false, false, true>(C.lds, C.tid, D / 2, 2048, 256, S, E); }
    PH_END
    for (int l = 0; l < NL; ++l) {
        PH_BEGIN { { pg8::MaskOrder S; S.init(WSP(bf16_t, WS_XB), WSP(bf16_t, WS_WIN) + (size_t)l * INW * D, D, D, T, l >= L8 ? 0u : 0xFFFFFFu, G, cb);
                     pg8::EpiStore<1> E{WSP(bf16_t, WS_PROJ), 0, 0, 0, 0, INW, WSP(float, WS_PART), 0, 1.f};
                     pg8::gemm_phase<pg8::EpiStore<1>, pg8::MaskOrder, true>(C.lds, C.tid, D, D, D, S, E); }
                   { pg8::MaskOrder S; S.init(WSP(unsigned char, WS_X8), WSP(bf16_t, WS_WIN) + (size_t)l * INW * D, D / 2, D / 2, T, l >= L8 ? 0xFFFFFFu : 0u, G, cb);
                     pg8::EpiStore<1, true> E{WSP(bf16_t, WS_PROJ), 0, 0, 0, 0, INW, WSP(float, WS_PART), 0, 1.f};
                     pg8::gemm_phase<pg8::EpiStore<1, true>, pg8::MaskOrder, true, false, true>(C.lds, C.tid, D / 2, D / 2, D / 2, S, E); } } PH_END
        PH_BEGIN phase_attn(C, l); PH_END
        PH_BEGIN { pg8::DenseOrder S; pg8::EpiResidualPart E{WSP(bf16_t, WS_XB), WSP(float, WS_PART), 0, l >= L8X ? WSP(unsigned char, WS_X8) : nullptr, l >= L8B ? 1.f / W8S : 1.f};
                   if (l >= L8B) { S.init(WSP(bf16_t, WS_MIX), WSP(bf16_t, WS_WOUT) + (size_t)l * D * D, D / 2, D / 2, T, D, G, cb);
                       pg8::gemm_phase<pg8::EpiResidualPart, pg8::DenseOrder, false, false, true>(C.lds, C.tid, D / 2, D / 2, D / 2, S, E); }
                   else { S.init(WSP(bf16_t, WS_MIX), WSP(bf16_t, WS_WOUT) + (size_t)l * D * D, D, D, T, D, G, cb);
                       pg8::gemm_phase<pg8::EpiResidualPart, pg8::DenseOrder, false>(C.lds, C.tid, D, D, D, S, E); } } PH_END
        PH_BEGIN { if (l + 1 < NL && G >= 256 && cb >= 128) convert_pull(C, l + 1, Q_X1, nullptr);
                   pg8::MultiOrder S{(const char*)WSP(bf16_t, WS_XB), (const char*)(WSP(bf16_t, WS_WQK) + (size_t)l * NB * 1024 * D), (size_t)SEQ * D * 2, 0, 0, (size_t)1024 * D * 2, 0, 0, 0, 0, 0, 16, 4, NB, D, D, XCD_G(128), XCD_C(128)};
                   pg8::EpiSoftmaxP E{WSP(bf16_t, WS_P), WSP(float, WS_PART), l >= L8X ? 1 : 0, l >= L8X ? 1.f / V8S : 1.f};
                   if (l >= L8X) { S.A = (const char*)WSP(unsigned char, WS_X8); S.a1 = (size_t)SEQ * D; S.lda = D / 2; S.ldb = D / 2; S.B = (const char*)WSP(unsigned char, WS_WQK) + (size_t)l * NB * 1024 * D; S.b1 = (size_t)1024 * D;
                       pg8::gemm_phase<pg8::EpiSoftmaxP, pg8::MultiOrder, false, false, true>(C.lds, C.tid, D / 2, D / 2, D / 2, S, E); }
                   else pg8::gemm_phase<pg8::EpiSoftmaxP, pg8::MultiOrder, false>(C.lds, C.tid, D, D, D, S, E); } PH_END
        PH_BEGIN { pg8::MultiOrder S{(const char*)WSP(bf16_t, WS_P), (const char*)(WSP(bf16_t, WS_VOT) + (size_t)l * NB * D * 1024), (size_t)SEQ * 1024 * 2, 0, 0, (size_t)D * 1024 * 2, 0, 0, 0, 0, 0, 16, 8, NB, 1024, 1024, XCD_G(256), XCD_C(256)};
                   pg8::EpiResidualPart E{WSP(bf16_t, WS_XB), WSP(float, WS_PART), (size_t)SEQ, l >= L8M ? WSP(unsigned char, WS_X8) : nullptr, l >= L8X ? 1.f / (P8S * V8S) : 1.f};
                   if (l >= L8X) { S.a1 = (size_t)SEQ * 1024; S.lda = 512; S.ldb = 512; S.B = (const char*)WSP(unsigned char, WS_VOT) + (size_t)l * NB * D * 1024; S.b1 = (size_t)D * 1024;
                       pg8::gemm_phase<pg8::EpiResidualPart, pg8::MultiOrder, false, false, true>(C.lds, C.tid, 512, 512, 512, S, E); }
                   else pg8::gemm_phase<pg8::EpiResidualPart, pg8::MultiOrder, false>(C.lds, C.tid, 1024, 1024, 1024, S, E); } PH_END
        PH_BEGIN phase_router(C, l); PH_END
        PH_BEGIN { pg8::MoeOrder<2, true> S{(int)(WSP(unsigned, WS_CTL) + CW_CNT + l * NE * CNT_STRIDE)[(C.lane & 31) * CNT_STRIDE], WSP(int, WS_LTOK), (const char*)WSP(bf16_t, WS_XB), (const char*)(WSP(bf16_t, WS_W13) + (size_t)l * NE * 512 * D), (size_t)512 * D * 2, D, D, G, cb};
                   { pg8::Unit u0; if (l + 1 < NL && !S.next(0, u0)) convert_pull(C, l + 1, Q_UP, nullptr); }
                   if (l >= L8M) { S.A = (const char*)WSP(unsigned char, WS_X8); S.bstride = (size_t)512 * D; S.lda = D / 2; S.ldb = D / 2;
                       pg8::EpiMoeUpF<true> E{WSP(bf16_t, WS_HID), WSP(float, WS_LW), WSP(float, WS_LR)};
                       pg8::gemm_phase<pg8::EpiMoeUpF<true>, pg8::MoeOrder<2, true>, true, true, true>(C.lds, C.tid, D / 2, D / 2, D / 2, S, E); }
                   else { pg8::EpiMoeUpF<> E{WSP(bf16_t, WS_HID), WSP(float, WS_LW), WSP(float, WS_LR)};
                       pg8::gemm_phase<pg8::EpiMoeUpF<>, pg8::MoeOrder<2, true>, true, true>(C.lds, C.tid, D, D, D, S, E); } } PH_END
        PH_BEGIN { pg8::MoeOrder<8, false> S{(int)(WSP(unsigned, WS_CTL) + CW_CNT + l * NE * CNT_STRIDE)[(C.lane & 31) * CNT_STRIDE], WSP(int, WS_LTOK), (const char*)WSP(bf16_t, WS_HID), (const char*)(WSP(bf16_t, WS_W2) + (size_t)l * NE * D * DE), (size_t)D * DE * 2, DE, DE, G, cb};
                   if (l >= L8M) { S.bstride = (size_t)D * DE; S.lda = DE / 2; S.ldb = DE / 2;
                       pg8::EpiMoeDownF<true> E{WSP(bf16_t, WS_Y), WSP(int, WS_LTOK)};
                       pg8::gemm_phase<pg8::EpiMoeDownF<true>, pg8::MoeOrder<8, false>, true, false, true>(C.lds, C.tid, DE / 2, DE / 2, DE / 2, S, E); }
                   else { pg8::EpiMoeDownF<> E{WSP(bf16_t, WS_Y), WSP(int, WS_LTOK)};
                       pg8::gemm_phase<pg8::EpiMoeDownF<>, pg8::MoeOrder<8, false>, true, false>(C.lds, C.tid, DE, DE, DE, S, E); } } PH_END
        PH_BEGIN phase_combine(C, l); if (l + 1 < NL) convert_pull(C, l + 1, LAYER_ITEMS, nullptr); PH_END
    }
}

extern "C" void kernel_launch(void* const* d_in, const int* in_sizes, int n_in, void* d_out, int out_size, void* d_ws, size_t ws_size, hipStream_t stream) {
    static int grid = 0;
    if (grid == 0) {
        if (n_in != 23 || in_sizes[0] != T * D || out_size != T * D || ws_size < WS_END) {
            fprintf(stderr, "kernel_launch: unexpected problem (n_in %d, in0 %d, out %d, ws %zu < %zu); nothing launched\n", n_in, n_in > 0 ? in_sizes[0] : -1, out_size, ws_size, (size_t)WS_END);
            grid = -1; return; }
        int dev = 0, cus = 0, per_cu = 0;
        if (hipGetDevice(&dev) != hipSuccess || hipDeviceGetAttribute(&cus, hipDeviceAttributeMultiprocessorCount, dev) != hipSuccess) { grid = -1; return; }
        if (hipFuncSetAttribute((const void*)mk_fwd, hipFuncAttributeMaxDynamicSharedMemorySize, LDS_BYTES) != hipSuccess) { fprintf(stderr, "kernel_launch: hipFuncSetAttribute failed\n"); grid = -1; return; }
        if (hipOccupancyMaxActiveBlocksPerMultiprocessor(&per_cu, (const void*)mk_fwd, NTHREADS, LDS_BYTES) != hipSuccess || per_cu < 1) {
            fprintf(stderr, "kernel_launch: occupancy query reports %d workgroups per CU\n", per_cu); (void)hipGetLastError(); grid = -1; return; }
        grid = cus;
    }
    if (grid < 0) return;
    if (hipMemsetAsync((char*)d_ws + WS_CTL, 0, CTL_BYTES, stream) != hipSuccess) return;
    Args a{};
    for (int i = 0; i < 23; ++i) a.in[i] = (const float*)d_in[i];
    a.out = (float*)d_out; a.ws = (unsigned char*)d_ws;
#if MK_MULTI
    for (int p = 0; p < NPH; ++p) { a.ph_lo = p; a.ph_hi = p + 1; hipLaunchKernelGGL(mk_fwd, dim3(grid), dim3(NTHREADS), LDS_BYTES, stream, a); }
#else
    a.ph_lo = 0; a.ph_hi = NPH;
    hipLaunchKernelGGL(mk_fwd, dim3(grid), dim3(NTHREADS), LDS_BYTES, stream, a);
#endif
    const hipError_t le = hipPeekAtLastError();
    if (le != hipSuccess) fprintf(stderr, "kernel_launch: launch failed: %s\n", hipGetErrorName(le));
}
```

```cpp
#include <hip/hip_runtime.h>
#include <cstdio>
#include <cstdint>

#ifndef MK_MULTI
#define MK_MULTI 0
#endif

typedef unsigned short bf16_t;
typedef short bf16x8 __attribute__((ext_vector_type(8)));
typedef int i32x4 __attribute__((ext_vector_type(4)));
typedef int i32x8 __attribute__((ext_vector_type(8)));
typedef float f32x16 __attribute__((ext_vector_type(16)));
typedef float f32x4 __attribute__((ext_vector_type(4)));
typedef unsigned u32x4 __attribute__((ext_vector_type(4)));
typedef unsigned u32x2 __attribute__((ext_vector_type(2)));
#define LAS __attribute__((address_space(3)))
#define GAS __attribute__((address_space(1)))
#define DI __device__ __forceinline__

constexpr int T = 8192, D = 2048, SEQ = 4096, NB = 2, NL = 4, INW = 6144;
constexpr int MEM = 256, MT = NB * MEM, NE = 32, DE = 256;
constexpr float EPS = 1e-6f;
constexpr float LOG2E = 1.4426950408889634f;
constexpr float SC_A = 0.08838834764831845f * LOG2E;
constexpr float SC_B = 0.125f * LOG2E;
constexpr float SC_X = 0.04419417382415922f * LOG2E;
constexpr int TABB_N = 640, TABB_OFF = 511;
constexpr int TABA_N = 320, TABA_OFF = 256;

constexpr size_t MiB = 1u << 20;
constexpr size_t WS_CTL = 0, CTL_BYTES = 1 * MiB;
constexpr int CW_BAR = 4096;
constexpr int CW_CNT = 16384, CNT_STRIDE = 16;
constexpr int CW_QH = 8192;
constexpr int CW_DONE = 8448;
constexpr size_t WS_TABB = 1 * MiB, WS_TABA = WS_TABB + 32768, WS_LAM = WS_TABB + 131072, WS_RMEM = WS_TABB + 135168;
static_assert(8 * TABB_N * 4 <= 32768 && NL * 8 * TABA_N * 4 <= 131072 - 32768, "bias tables fit their slots");
constexpr size_t WS_PART = 2 * MiB;
constexpr size_t WS_WRT = 3 * MiB;
constexpr size_t WS_LTOK = 5 * MiB, WS_LW = 6 * MiB, WS_LR = 7 * MiB;
constexpr size_t WS_XB = 16 * MiB, WS_MEMB = 48 * MiB, WS_KVB = 50 * MiB, WS_WQK = 66 * MiB, WS_VOT = 98 * MiB;
constexpr size_t WS_PROJ = 130 * MiB, WS_MIX = 226 * MiB, WS_P = 258 * MiB, WS_HID = 274 * MiB, WS_Y = 286 * MiB, WS_SCR = 350 * MiB;
constexpr size_t WS_WIN = 544 * MiB, WS_WOUT = 640 * MiB, WS_WQS = 672 * MiB, WS_WKV = 704 * MiB, WS_WXO = 768 * MiB, WS_W13 = 800 * MiB, WS_W2 = 1056 * MiB;
constexpr size_t WS_X8 = 1184 * MiB, WS_END = 1200 * MiB;
#ifndef F8_FROM
#define F8_FROM 1
#endif
#ifndef F8M_FROM
#define F8M_FROM 0
#endif
constexpr int L8M = F8M_FROM;
constexpr int L8 = F8_FROM;
constexpr float H8S = 16.f;
constexpr float Y8S = 16.f;
#ifndef F8B_FROM
#define F8B_FROM 2
#endif
constexpr int L8B = F8B_FROM;
#ifndef F8X_FROM
#define F8X_FROM 0
#endif
constexpr int L8X = F8X_FROM; static_assert(F8X_FROM == 0, "the prologue builds only the e4m3 Wqk / VoT");
constexpr float Q8S = 512.f;
constexpr float P8S = 256.f, V8S = 16.f;
constexpr int HID_ROWS = 24576;

constexpr int NWAVES = 8, NTHREADS = 512;
constexpr int LDS_BYTES = 147456;
constexpr int LDS_MISC = 139264;

DI float bf2f(bf16_t v) { return __uint_as_float((unsigned)v << 16); }
DI unsigned f2bf(float f) { unsigned u = __float_as_uint(f); return (u + 0x7fffu + ((u >> 16) & 1u)) >> 16; }
DI unsigned pk2(float lo, float hi) { return f2bf(lo) | (f2bf(hi) << 16); }
DI float bpx(float v, int lane, int m) { return __int_as_float(__builtin_amdgcn_ds_bpermute((lane ^ m) << 2, __float_as_int(v))); }
DI float sum_x16(float v, int lane) { return v + bpx(v, lane, 16); }
DI float max_x16(float v, int lane) { return fmaxf(v, bpx(v, lane, 16)); }
DI float sum_x32(float v, int lane) { return v + bpx(v, lane, 32); }
DI float max_x32(float v, int lane) { return fmaxf(v, bpx(v, lane, 32)); }
DI float wave_sum(float v, int lane) {
#pragma unroll
    for (int o = 1; o < 64; o <<= 1) v += bpx(v, lane, o);
    return v; }
DI float wave_max(float v, int lane) {
#pragma unroll
    for (int o = 1; o < 64; o <<= 1) v = fmaxf(v, bpx(v, lane, o));
    return v; }
DI float lane_get(float v, int src) { return __int_as_float(__builtin_amdgcn_ds_bpermute(src << 2, __float_as_int(v))); }
DI int crow(int r, int hi) { return (r & 3) + 8 * (r >> 2) + 4 * hi; }
#define MFMA32(a, b, c) __builtin_amdgcn_mfma_f32_32x32x16_bf16((a), (b), (c), 0, 0, 0)
#define LDS_WAIT() asm volatile("s_waitcnt lgkmcnt(0)" ::: "memory")
#define AT_BAR() asm volatile("s_waitcnt vmcnt(0) lgkmcnt(0)\n\ts_barrier" ::: "memory")

#define XB_TMO      128
#define XB_XCNT(j)  (256  + 64 * (j))
#define XB_XSUB(j)  (1280 + 64 * (j))
#define XB_XGEN(j)  (2304 + 64 * (j))
#define XB_TOP      3328
#define XB_TOPGEN   3392
#define XCD_BAR_WORDS 3456
#define XB_SPIN_CAP (1u << 18)
__device__ __forceinline__ unsigned xb_ld(unsigned* p)              { return __hip_atomic_load(p, __ATOMIC_RELAXED, __HIP_MEMORY_SCOPE_AGENT); }
__device__ __forceinline__ unsigned xb_add(unsigned* p, unsigned v) { return __hip_atomic_fetch_add(p, v, __ATOMIC_RELAXED, __HIP_MEMORY_SCOPE_AGENT); }
__device__ __forceinline__ unsigned xb_xcc_id() { return (unsigned)__builtin_amdgcn_s_getreg((3 << 11) | 20) & 0xFu; }
#define XB_SPIN(cond, bar) do { unsigned _sp = 0; while (cond) { __builtin_amdgcn_s_sleep(1); \
    if ((++_sp & 255u) == 0u) { if (xb_ld(&(bar)[XB_TMO])) break; if (_sp > XB_SPIN_CAP) { atomicAdd(&(bar)[XB_TMO], 1u); break; } } } } while (0)
struct XcdBarrier { unsigned* bar; unsigned x; volatile LAS unsigned* st; };
__device__ __forceinline__ XcdBarrier xcd_barrier_post(unsigned* bar, volatile LAS unsigned* st) {
    XcdBarrier b; b.bar = bar; b.x = xb_xcc_id(); b.st = st;
    if (threadIdx.x == 0) (void)xb_add(&bar[XB_XCNT(b.x)], 1u);
    return b;
}
__device__ __forceinline__ void xcd_barrier_complete(unsigned* bar, unsigned x, unsigned& nloc, unsigned& nx) {
    const unsigned G = gridDim.x * gridDim.y * gridDim.z;
    unsigned sum, cnt, mine, sp = 0u;
    for (;;) {
        sum = 0u; cnt = 0u; mine = 0u;
#pragma unroll
        for (unsigned j = 0; j < 16; ++j) { const unsigned c = xb_ld(&bar[XB_XCNT(j)]); sum += c; cnt += (c > 0u) ? 1u : 0u; mine = (j == x) ? c : mine; }
        if (sum == G) break;
        __builtin_amdgcn_s_sleep(1);
        if ((++sp & 255u) == 0u) { if (xb_ld(&bar[XB_TMO])) break; if (sp > XB_SPIN_CAP) { atomicAdd(&bar[XB_TMO], 1u); break; } }
    }
    nloc = mine > 0u ? mine : 1u; nx = cnt > 0u ? cnt : 1u;
}
__device__ __forceinline__ void xcd_barrier(const XcdBarrier& b, const int tid) {
    asm volatile("s_waitcnt vmcnt(0)" ::: "memory");
    __syncthreads();
    if (tid == 0) {
        unsigned* bar = b.bar;
        __builtin_amdgcn_s_waitcnt(0);
        unsigned nloc = b.st[0], nx = b.st[1];
        if (nloc == 0u) { xcd_barrier_complete(bar, b.x, nloc, nx); b.st[0] = nloc; b.st[1] = nx; }
        const unsigned old = xb_add(&bar[XB_XSUB(b.x)], 1u);
        const unsigned gen = old / nloc;
        if (old + 1u == (gen + 1u) * nloc) {
            __builtin_amdgcn_fence(__ATOMIC_RELEASE, "agent");
            asm volatile("s_waitcnt vmcnt(0)" ::: "memory");
            const unsigned og = xb_add(&bar[XB_TOP], 1u);
            const unsigned tg = og / nx;
            if (og + 1u == (tg + 1u) * nx) xb_add(&bar[XB_TOPGEN], 1u);
            else XB_SPIN(xb_ld(&bar[XB_TOPGEN]) == tg, bar);
            __builtin_amdgcn_fence(__ATOMIC_ACQUIRE, "agent");
            xb_add(&bar[XB_XGEN(b.x)], 1u);
            asm volatile("s_waitcnt vmcnt(0)" ::: "memory");
        } else {
            XB_SPIN(xb_ld(&bar[XB_XGEN(b.x)]) == gen, bar);
            __builtin_amdgcn_fence(__ATOMIC_ACQUIRE, "agent");
            asm volatile("s_waitcnt vmcnt(0)" ::: "memory");
        }
    }
    __syncthreads();
}

struct Args { const float* in[23]; float* out; unsigned char* ws; int ph_lo, ph_hi; };
enum { I_X = 0, I_MEM, I_NMIX, I_WIN, I_RELA, I_T5, I_DLAM, I_SUBLN, I_WOUT, I_NCROSS, I_NMEM, I_WXQ, I_WXKV, I_WXO, I_NFFN, I_WG, I_BG, I_WE, I_BE, I_W1, I_W3, I_W2, I_NFIN };

struct Ctx {
    const __attribute__((address_space(4))) unsigned char* ka;
    float* out; GAS unsigned char* ws;
    LAS unsigned char* lds;
    int tid, lane, wave, gw, ngw;
};
#define WSP(type, off) ((type*)(GAS type*)(C.ws + (off)))
#define CIN(i) ((const float*)*(const GAS float* const __attribute__((address_space(4)))*)(C.ka + 8 * (i)))

DI unsigned cvtpk_rne(float lo, float hi) { unsigned r; asm volatile("v_cvt_pk_bf16_f32 %0, %1, %2" : "=v"(r) : "v"(lo), "v"(hi)); return r; }
DI unsigned pk8(float a, float b, float c, float d) { int r = __builtin_amdgcn_cvt_pk_fp8_f32(a, b, 0, false); r = __builtin_amdgcn_cvt_pk_fp8_f32(c, d, r, true); return (unsigned)r; }
DI float clamp8(float v) { return __builtin_amdgcn_fmed3f(v, -448.f, 448.f); }
constexpr float W8S = 64.f;
template <bool F8 = false> DI void tr_item(const float* src, int ldsrc, int k0, int n0, const float* gk, float nscale, void* dst_, int lddst, int drow0, int lane) {
    bf16_t* dst = (bf16_t*)dst_;
    const int n4 = lane & 15, kg = lane >> 4;
    const float* sp = src + (size_t)(k0 + kg * 16) * ldsrc + n0 + 4 * n4;
    f32x4 v[16];
#pragma unroll
    for (int j = 0; j < 16; ++j) v[j] = __builtin_nontemporal_load((const f32x4*)(sp + (size_t)j * ldsrc));
    float g[16];
    if (gk) {
#pragma unroll
        for (int j4 = 0; j4 < 4; ++j4) { const f32x4 t = *(const f32x4*)(gk + k0 + kg * 16 + 4 * j4); g[4 * j4] = t.x * nscale; g[4 * j4 + 1] = t.y * nscale; g[4 * j4 + 2] = t.z * nscale; g[4 * j4 + 3] = t.w * nscale; }
    } else {
#pragma unroll
        for (int j = 0; j < 16; ++j) g[j] = nscale;
    }
    if constexpr (F8) { unsigned char* dp8 = (unsigned char*)dst_ + (size_t)(drow0 + 4 * n4) * lddst + k0 + kg * 16;
#pragma unroll
        for (int q = 0; q < 4; ++q) { u32x4 o;
#pragma unroll
            for (int c = 0; c < 4; ++c) o[c] = pk8(v[4 * c][q] * g[4 * c], v[4 * c + 1][q] * g[4 * c + 1], v[4 * c + 2][q] * g[4 * c + 2], v[4 * c + 3][q] * g[4 * c + 3]);
            *(u32x4*)(dp8 + (size_t)q * lddst) = o; }
        return; }
    bf16_t* dp = dst + (size_t)(drow0 + 4 * n4) * lddst + k0 + kg * 16;
#pragma unroll
    for (int q = 0; q < 4; ++q)
#pragma unroll
        for (int c = 0; c < 2; ++c) { u32x4 o;
            o.x = cvtpk_rne(v[8 * c][q] * g[8 * c], v[8 * c + 1][q] * g[8 * c + 1]); o.y = cvtpk_rne(v[8 * c + 2][q] * g[8 * c + 2], v[8 * c + 3][q] * g[8 * c + 3]);
            o.z = cvtpk_rne(v[8 * c + 4][q] * g[8 * c + 4], v[8 * c + 5][q] * g[8 * c + 5]); o.w = cvtpk_rne(v[8 * c + 6][q] * g[8 * c + 6], v[8 * c + 7][q] * g[8 * c + 7]);
            *(u32x4*)(dp + (size_t)q * lddst + 8 * c) = o; }
}

DI int t5_bucket(int rel) {
    const int ret = rel > 0 ? 16 : 0; const int n = rel < 0 ? -rel : rel;
    const float nf = (float)(n > 8 ? n : 8);
    int large = 8 + (int)(logf(nf / 8.f) / logf(64.f) * 8.f);
    large = large < 15 ? large : 15;
    return ret + (n < 8 ? n : large);
}

constexpr int LI_WIN = 32 * 96, LI_WOUT = 1024, LI_W13 = NE * 128, LI_W2 = NE * 128, LAYER_ITEMS = LI_WIN + LI_WOUT + LI_W13 + LI_W2;
DI void convert_layer_item(const Ctx& C, int l, int it, int lane) {
    if (it < LI_WIN) { const int kb = it / 96, nb = it % 96, n0 = nb * 64;
        if (l >= L8) { tr_item<true>(CIN(I_WIN) + (size_t)l * D * INW, INW, kb * 64, n0, CIN(I_NMIX) + l * D, W8S, (unsigned char*)(WSP(bf16_t, WS_WIN) + (size_t)l * INW * D), D, n0, lane); return; }
        const float ns = (n0 < 1024) ? SC_A : ((n0 >= 3072 && n0 < 4096) ? SC_B : 1.f);
        tr_item(CIN(I_WIN) + (size_t)l * D * INW, INW, kb * 64, n0, CIN(I_NMIX) + l * D, ns, WSP(bf16_t, WS_WIN) + (size_t)l * INW * D, D, n0, lane); return; }
    it -= LI_WIN;
    if (it < LI_WOUT) { const int kb = it / 32, nb = it % 32;
        if (l >= L8B) { tr_item<true>(CIN(I_WOUT) + (size_t)l * D * D, D, kb * 64, nb * 64, nullptr, W8S, (unsigned char*)(WSP(bf16_t, WS_WOUT) + (size_t)l * D * D), D, nb * 64, lane); return; }
        tr_item(CIN(I_WOUT) + (size_t)l * D * D, D, kb * 64, nb * 64, nullptr, 1.f, WSP(bf16_t, WS_WOUT) + (size_t)l * D * D, D, nb * 64, lane); return; }
    it -= LI_WOUT;
    if (it < LI_W13) { const int le = l * NE + it / 128, r = it % 128, kb = r / 4, nb = r % 4;
        bf16_t* dst = WSP(bf16_t, WS_W13) + (size_t)le * 512 * D; const int dr = (nb >> 1) * 256 + (nb & 1) * 64;
        if (l >= L8M) { unsigned char* d8 = (unsigned char*)(WSP(bf16_t, WS_W13) + (size_t)l * NE * 512 * D) + (size_t)(it / 128) * 512 * D;
            tr_item<true>(CIN(I_W1) + (size_t)le * D * DE, DE, kb * 64, nb * 64, CIN(I_NFFN) + l * D, W8S, d8, D, dr, lane);
            tr_item<true>(CIN(I_W3) + (size_t)le * D * DE, DE, kb * 64, nb * 64, CIN(I_NFFN) + l * D, W8S, d8, D, dr + 128, lane); return; }
        tr_item(CIN(I_W1) + (size_t)le * D * DE, DE, kb * 64, nb * 64, CIN(I_NFFN) + l * D, 1.f, dst, D, dr, lane);
        tr_item(CIN(I_W3) + (size_t)le * D * DE, DE, kb * 64, nb * 64, CIN(I_NFFN) + l * D, 1.f, dst, D, dr + 128, lane); return; }
    it -= LI_W13;
    { const int le = l * NE + it / 128, r = it % 128, kb = r / 32, nb = r % 32;
      if (l >= L8M) { tr_item<true>(CIN(I_W2) + (size_t)le * DE * D, D, kb * 64, nb * 64, nullptr, W8S, (unsigned char*)(WSP(bf16_t, WS_W2) + (size_t)l * NE * D * DE) + (size_t)(it / 128) * D * DE, DE, nb * 64, lane); return; }
      tr_item(CIN(I_W2) + (size_t)le * DE * D, D, kb * 64, nb * 64, nullptr, 1.f, WSP(bf16_t, WS_W2) + (size_t)le * D * DE, DE, nb * 64, lane); }
}
DI void convert_pull(const Ctx& C, int l, int quota, const unsigned* stop) {
    unsigned* qh = WSP(unsigned, WS_CTL) + CW_QH + l;
    for (int n = 0; n < quota; n += 4) {
        unsigned it = 0, st = 0;
        if (C.lane == 0) { if (stop) st = __hip_atomic_load(stop, __ATOMIC_RELAXED, __HIP_MEMORY_SCOPE_AGENT);
                           it = __hip_atomic_fetch_add(qh, 4u, __ATOMIC_RELAXED, __HIP_MEMORY_SCOPE_AGENT); }
        it = (unsigned)__builtin_amdgcn_readfirstlane((int)it); st = (unsigned)__builtin_amdgcn_readfirstlane((int)st);
        if (it >= (unsigned)LAYER_ITEMS) break;
        for (int k = 0; k < 4; ++k) convert_layer_item(C, l, (int)it + k, C.lane);
        if (st != 0u) break;
    }
}
static_assert(LAYER_ITEMS % 4 == 0, "queue batches of 4");
DI void phase_prologue(const Ctx& C) {
    const int gw = C.gw, ngw = C.ngw, lane = C.lane;
    for (int it = gw; it < LAYER_ITEMS; it += ngw) convert_layer_item(C, 0, it, lane);
    for (int it = gw; it < NL * 2048; it += ngw) { const int l = it / 2048, r = it % 2048, kb = r / 64, nb = r % 64;
        tr_item<true>(CIN(I_WXKV) + (size_t)l * D * 4096, 4096, kb * 64, nb * 64, CIN(I_NMEM) + l * D, W8S, WSP(unsigned char, WS_WKV) + (size_t)l * 4096 * D, D, nb * 64, lane); }
    for (int it = gw; it < NL * 1024; it += ngw) { const int l = it / 1024, r = it % 1024, kb = r / 32, nb = r % 32;
        tr_item<true>(CIN(I_WXO) + (size_t)l * D * D, D, kb * 64, nb * 64, nullptr, W8S, WSP(unsigned char, WS_WXO) + (size_t)l * D * D, D, nb * 64, lane); }
    { const size_t n8 = (size_t)NL * D * D / 8; const float* src = CIN(I_WXQ); unsigned char* dst = WSP(unsigned char, WS_WQS);
      for (size_t i = (size_t)gw * 64 + lane; i < n8; i += (size_t)ngw * 64) { const size_t e = i * 8; const int row = (int)((e / D) % D), l = (int)(e / ((size_t)D * D));
          const float sc = CIN(I_NCROSS)[l * D + row] * (SC_X * Q8S); const f32x4 a = __builtin_nontemporal_load((const f32x4*)(src + e)), b = __builtin_nontemporal_load((const f32x4*)(src + e + 4));
          u32x2 o; o.x = pk8(a.x * sc, a.y * sc, a.z * sc, a.w * sc); o.y = pk8(b.x * sc, b.y * sc, b.z * sc, b.w * sc);
          *(u32x2*)(dst + e) = o; } }
    { bf16_t* whi = WSP(bf16_t, WS_WRT); bf16_t* wlo = whi + (size_t)NL * 64 * D;
      for (int i = gw * 64 + lane; i < NL * 64 * D; i += ngw * 64) { const int l = i / (64 * D), rem = i % (64 * D), f = rem >> 9, L = (rem >> 3) & 63, jj = rem & 7;
          const int blk = f & 1, s16 = (f >> 1) & 15, w8 = f >> 5, j = blk * 32 + (L & 31), k = w8 * 256 + s16 * 16 + 8 * (L >> 5) + jj;
          float w = 0.f;
          if (j < 36) w = (j < 4 ? CIN(I_WG)[((size_t)l * D + k) * 4 + j] : CIN(I_WE)[((size_t)l * D + k) * 32 + (j - 4)]) * CIN(I_NFFN)[l * D + k];
          const unsigned h = f2bf(w); whi[i] = (bf16_t)h; wlo[i] = (bf16_t)f2bf(w - __uint_as_float(h << 16)); } }
    { bf16_t* xb = WSP(bf16_t, WS_XB); float* part = WSP(float, WS_PART);
      for (int row = gw; row < T + MT; row += ngw) {
          const bool isx = row < T; const int rr = isx ? row : row - T;
          const float* src = (isx ? CIN(I_X) : CIN(I_MEM)) + (size_t)rr * D; bf16_t* dst = (isx ? xb : WSP(bf16_t, WS_MEMB)) + (size_t)rr * D;
          float ss = 0.f; f32x4 vv[8];
#pragma unroll
          for (int j = 0; j < 8; ++j) vv[j] = __builtin_nontemporal_load((const f32x4*)(src + j * 256 + lane * 4));
          __builtin_amdgcn_sched_barrier(0);
#pragma unroll
          for (int j = 0; j < 8; ++j) { const f32x4 v = vv[j];
              u32x2 o; o.x = pk2(v.x, v.y); o.y = pk2(v.z, v.w);
              if (isx) *(u32x2*)(dst + j * 256 + lane * 4) = o;
              else *(unsigned*)(WSP(unsigned char, WS_MEMB) + (size_t)rr * D + j * 256 + lane * 4) = pk8(clamp8(v.x), clamp8(v.y), clamp8(v.z), clamp8(v.w));
              const float a = bf2f((bf16_t)(o.x & 0xffff)), b = bf2f((bf16_t)(o.x >> 16)), c = bf2f((bf16_t)(o.y & 0xffff)), d = bf2f((bf16_t)(o.y >> 16));
              ss += (a * a + b * b) + (c * c + d * d); }
          ss = wave_sum(ss, C.lane);
          if (isx) { if (lane < 32) part[(size_t)rr * 32 + lane] = lane == 0 ? ss : 0.f; }
          else if (lane == 0) WSP(float, WS_RMEM)[rr] = rsqrtf(ss * (1.f / D) + EPS);
      } }
    if (blockIdx.x == 0) {
        float* tb = WSP(float, WS_TABB); float* ta = WSP(float, WS_TABA);
        for (int i = C.tid; i < 8 * TABB_N; i += NTHREADS) { const int h = i / TABB_N, idx = i % TABB_N; const int rel = idx - TABB_OFF;
            tb[i] = (rel <= 63) ? CIN(I_T5)[t5_bucket(rel) * 8 + h] * LOG2E : 0.f; }
        for (int i = C.tid; i < NL * 8 * TABA_N; i += NTHREADS) { const int idx = i % TABA_N, h = (i / TABA_N) % 8, l = i / (8 * TABA_N); int rel = idx - TABA_OFF; rel = rel > 128 ? 128 : (rel < -128 ? -128 : rel);
            ta[i] = CIN(I_RELA)[((size_t)l * 257 + (rel + 128)) * 8 + h] * LOG2E; }
        if (C.wave < NL) { const int l = C.wave; const float* lv = CIN(I_DLAM) + l * 256;
            const float s1 = wave_sum(lv[lane] * lv[64 + lane], C.lane), s2 = wave_sum(lv[128 + lane] * lv[192 + lane], C.lane);
            if (lane == 0) WSP(float, WS_LAM)[l] = expf(s1) - expf(s2) + (0.8f - 0.6f * expf(-0.3f * (float)l)); }
    }
}

DI void phase_router(const Ctx& C, int l) {
    const bf16_t* xb = WSP(bf16_t, WS_XB); const float* part = WSP(float, WS_PART);
    const bf16_t* whi = WSP(bf16_t, WS_WRT) + (size_t)l * 64 * D; const bf16_t* wlo = whi + (size_t)NL * 64 * D;
    unsigned* cnt = WSP(unsigned, WS_CTL) + CW_CNT + l * NE * CNT_STRIDE;
    int* ltok = WSP(int, WS_LTOK); float* lw = WSP(float, WS_LW); float* lr = WSP(float, WS_LR);
    const int lane = C.lane, wid = C.wave, r32 = lane & 31, hi = lane >> 5;
    LAS float* red = (LAS float*)C.lds;
    LAS float* lg = (LAS float*)(C.lds + 65536);
    volatile LAS unsigned* lcnt = (volatile LAS unsigned*)(C.lds + 65536 + 8192); volatile LAS unsigned* gbase = lcnt + 32;
    for (int tb = (int)blockIdx.x; tb < T / 32; tb += (int)gridDim.x) {
        const int t0 = tb * 32, k0 = wid * 256;
        f32x16 a0 = {}, a1 = {};
        const char* xp = (const char*)(xb + (size_t)t0 * D + k0); unsigned xo = (unsigned)(r32 * D + 8 * hi) * 2u;
        const char* wh = (const char*)(whi + (size_t)(wid * 32) * 512); const char* wl = (const char*)(wlo + (size_t)(wid * 32) * 512); unsigned wo = (unsigned)lane * 16u;
        bf16x8 xf[3][2], fh[3][4], fl[3][4];
#define RT_LOAD(bf, s2) do { asm volatile("" : "+v"(xo), "+v"(wo)); _Pragma("unroll") for (int q = 0; q < 2; ++q) xf[bf][q] = *(const bf16x8*)(xp + 32 * ((s2) + q) + xo); \
            _Pragma("unroll") for (int q = 0; q < 4; ++q) { fh[bf][q] = *(const bf16x8*)(wh + (2 * (s2) + q) * 1024 + wo); fl[bf][q] = *(const bf16x8*)(wl + (2 * (s2) + q) * 1024 + wo); } __builtin_amdgcn_sched_barrier(0); } while (0)
#define RT_MMA(bf) do { _Pragma("unroll") for (int q = 0; q < 2; ++q) { \
                a0 = MFMA32(fh[bf][2 * q], xf[bf][q], a0);     a0 = MFMA32(fl[bf][2 * q], xf[bf][q], a0); \
                a1 = MFMA32(fh[bf][2 * q + 1], xf[bf][q], a1); a1 = MFMA32(fl[bf][2 * q + 1], xf[bf][q], a1); } __builtin_amdgcn_sched_barrier(0); } while (0)
        RT_LOAD(0, 0); RT_LOAD(1, 2);
        RT_LOAD(2, 4);  RT_MMA(0);
        RT_LOAD(0, 6);  RT_MMA(1);
        RT_LOAD(1, 8);  RT_MMA(2);
        RT_LOAD(2, 10); RT_MMA(0);
        RT_LOAD(0, 12); RT_MMA(1);
        RT_LOAD(1, 14); RT_MMA(2);
        RT_MMA(0); RT_MMA(1);
#undef RT_LOAD
#undef RT_MMA
#pragma unroll
        for (int i = 0; i < 16; ++i) red[(wid * 36 + crow(i, hi)) * 32 + r32] = a0[i];
        if (hi == 0) {
#pragma unroll
            for (int i = 0; i < 4; ++i) red[(wid * 36 + 32 + i) * 32 + r32] = a1[i];
        }
        AT_BAR();
        if (wid == 0) {
            if (lane < 32) lcnt[lane] = 0u;
            const f32x4* pp = (const f32x4*)(part + (size_t)(t0 + r32) * 32); float ps = 0.f;
#pragma unroll
            for (int q = 0; q < 8; ++q) { const f32x4 v = pp[q]; ps += (v.x + v.y) + (v.z + v.w); }
            const float rs = rsqrtf(ps * (1.f / D) + EPS);
#pragma unroll
            for (int oo = 0; oo < 18; ++oo) { const int o = hi * 18 + oo; float sacc = 0.f;
#pragma unroll
                for (int w = 0; w < 8; ++w) sacc += red[(w * 36 + o) * 32 + r32];
                lg[r32 * 40 + o] = sacc * rs + (o < 4 ? CIN(I_BG)[l * 4 + o] : CIN(I_BE)[l * 32 + (o - 4)]); }
            LDS_WAIT();
            if (hi == 0) {
                const LAS float* my = lg + r32 * 40; const int t = t0 + r32;
                const float g0 = my[0], g1 = my[1], g2 = my[2], g3 = my[3];
                int gs = 0; float gm = g0; if (g1 > gm) { gm = g1; gs = 1; } if (g2 > gm) { gm = g2; gs = 2; } if (g3 > gm) { gm = g3; gs = 3; }
                const float gate = 1.f / (expf(g0 - gm) + expf(g1 - gm) + expf(g2 - gm) + expf(g3 - gm));
                float v0 = -3.0e38f, v1 = -3.0e38f; int i0 = 0, i1 = 0;
#pragma unroll
                for (int i = 0; i < 8; ++i) { const float v = my[4 + gs * 8 + i];
                    if (v > v0) { v1 = v0; i1 = i0; v0 = v; i0 = i; } else if (v > v1) { v1 = v; i1 = i; } }
                const float e = expf(v1 - v0), w0 = gate / (1.f + e), w1 = gate * e / (1.f + e);
                const int ea = gs * 8 + i0, eb = gs * 8 + i1;
                const unsigned la = __hip_atomic_fetch_add((LAS unsigned*)lcnt + ea, 1u, __ATOMIC_RELAXED, __HIP_MEMORY_SCOPE_WORKGROUP), lb = __hip_atomic_fetch_add((LAS unsigned*)lcnt + eb, 1u, __ATOMIC_RELAXED, __HIP_MEMORY_SCOPE_WORKGROUP);
                LDS_WAIT();
                { const unsigned mine = lcnt[r32]; unsigned gb = 0u; if (mine) gb = atomicAdd(&cnt[r32 * CNT_STRIDE], mine); gbase[r32] = gb; }
                LDS_WAIT();
                const unsigned pa = gbase[ea] + la, pb = gbase[eb] + lb;
                ltok[(size_t)ea * T + pa] = t * 2;     lw[(size_t)ea * T + pa] = w0; lr[(size_t)ea * T + pa] = rs;
                ltok[(size_t)eb * T + pb] = t * 2 + 1; lw[(size_t)eb * T + pb] = w1; lr[(size_t)eb * T + pb] = rs;
            }
        }
        AT_BAR();
    }
}
DI void phase_combine(const Ctx& C, int l) {
    bf16_t* xb = WSP(bf16_t, WS_XB); const bf16_t* Y = WSP(bf16_t, WS_Y); float* part = WSP(float, WS_PART);
    for (int row = C.gw; row < T; row += C.ngw) {
        float xv[32]; float ss = 0.f;
#pragma unroll
        for (int j = 0; j < 4; ++j) { const size_t o = (size_t)row * D + j * 512 + C.lane * 8;
            const u32x4 a = __builtin_nontemporal_load((const u32x4*)(xb + o)); const u32x2 y0 = __builtin_nontemporal_load((const u32x2*)((const unsigned char*)Y + o)), y1 = __builtin_nontemporal_load((const u32x2*)((const unsigned char*)Y + (size_t)T * D + o));
#pragma unroll
            for (int h2 = 0; h2 < 2; ++h2) { const int w0 = (int)y0[h2], w1 = (int)y1[h2];
                const auto l0 = __builtin_amdgcn_cvt_pk_f32_fp8(w0, false), u0 = __builtin_amdgcn_cvt_pk_f32_fp8(w0, true), l1 = __builtin_amdgcn_cvt_pk_f32_fp8(w1, false), u1 = __builtin_amdgcn_cvt_pk_f32_fp8(w1, true);
                xv[j * 8 + 4 * h2]     = __uint_as_float(a[2 * h2] << 16)               + (l0[0] + l1[0]) * (1.f / Y8S);
                xv[j * 8 + 4 * h2 + 1] = __uint_as_float(a[2 * h2] & 0xffff0000u)       + (l0[1] + l1[1]) * (1.f / Y8S);
                xv[j * 8 + 4 * h2 + 2] = __uint_as_float(a[2 * h2 + 1] << 16)           + (u0[0] + u1[0]) * (1.f / Y8S);
                xv[j * 8 + 4 * h2 + 3] = __uint_as_float(a[2 * h2 + 1] & 0xffff0000u)   + (u0[1] + u1[1]) * (1.f / Y8S); } }
        if (l == NL - 1) {
#pragma unroll
            for (int i = 0; i < 32; ++i) ss += xv[i] * xv[i];
            const float rs = rsqrtf(wave_sum(ss, C.lane) * (1.f / D) + EPS);
#pragma unroll
            for (int j = 0; j < 4; ++j) { const int col = j * 512 + C.lane * 8; const f32x4 g0 = *(const f32x4*)(CIN(I_NFIN) + col), g1 = *(const f32x4*)(CIN(I_NFIN) + col + 4);
                f32x4 o0, o1; o0.x = xv[j * 8] * rs * g0.x; o0.y = xv[j * 8 + 1] * rs * g0.y; o0.z = xv[j * 8 + 2] * rs * g0.z; o0.w = xv[j * 8 + 3] * rs * g0.w;
                o1.x = xv[j * 8 + 4] * rs * g1.x; o1.y = xv[j * 8 + 5] * rs * g1.y; o1.z = xv[j * 8 + 6] * rs * g1.z; o1.w = xv[j * 8 + 7] * rs * g1.w;
                *(f32x4*)(C.out + (size_t)row * D + col) = o0; *(f32x4*)(C.out + (size_t)row * D + col + 4) = o1; }
        } else {
#pragma unroll
            for (int j = 0; j < 4; ++j) { u32x4 o;
#pragma unroll
                for (int q = 0; q < 4; ++q) { o[q] = pk2(xv[j * 8 + 2 * q], xv[j * 8 + 2 * q + 1]);
                    const float a = __uint_as_float(o[q] << 16), b = __uint_as_float(o[q] & 0xffff0000u); ss += a * a + b * b; }
                __builtin_nontemporal_store(o, (u32x4*)(xb + (size_t)row * D + j * 512 + C.lane * 8));
                if (l + 1 >= L8) { u32x2 e; e.x = pk8(clamp8(xv[j * 8]), clamp8(xv[j * 8 + 1]), clamp8(xv[j * 8 + 2]), clamp8(xv[j * 8 + 3])); e.y = pk8(clamp8(xv[j * 8 + 4]), clamp8(xv[j * 8 + 5]), clamp8(xv[j * 8 + 6]), clamp8(xv[j * 8 + 7]));
                __builtin_nontemporal_store(e, (u32x2*)(WSP(unsigned char, WS_X8) + (size_t)row * D + j * 512 + C.lane * 8)); } }
            ss = wave_sum(ss, C.lane);
            if (C.lane < 32) part[(size_t)row * 32 + C.lane] = C.lane == 0 ? ss : 0.f;
        }
    }
}

typedef short s16x4 __attribute__((ext_vector_type(4)));
#define AT_KSWZ(row, colB) ((row) * 256 + ((colB) ^ (((row) & 7) << 4)))
DI int at_v_rd_base(int lane) { return ((lane & 3) << 3) | (((lane >> 2) & 3) << 6) | (((lane >> 4) & 1) << 5) | (((lane >> 5) & 1) << 8); }
template <int OFF> DI s16x4 at_tr_read(int vb) { s16x4 r; asm volatile("ds_read_b64_tr_b16 %0, %1 offset:%2" : "=&v"(r) : "v"(vb), "i"(OFF) : "memory"); return r; }
DI unsigned at_cvtpk(float lo, float hi) { unsigned r; asm volatile("v_cvt_pk_bf16_f32 %0, %1, %2" : "=v"(r) : "v"(lo), "v"(hi)); return r; }
constexpr float AT_THR = 8.f;

template <int KS> DI void at_qk(f32x16& p0, f32x16& p1, LAS const unsigned char* Kt, int mapB, const bf16x8 (&qr)[8], float init, int r32, int hi) {
#pragma unroll
    for (int i = 0; i < 16; ++i) { p0[i] = init; p1[i] = init; }
    bf16x8 kb[KS][2];
#pragma unroll
    for (int d0 = 0; d0 < KS; ++d0) { const int cb = mapB + (d0 * 16 + hi * 8) * 2;
        kb[d0][0] = *(const LAS bf16x8*)(Kt + AT_KSWZ(r32, cb)); kb[d0][1] = *(const LAS bf16x8*)(Kt + AT_KSWZ(32 + r32, cb)); }
    __builtin_amdgcn_sched_barrier(0);
#pragma unroll
    for (int d0 = 0; d0 < KS; ++d0) { p0 = MFMA32(kb[d0][0], qr[d0], p0); p1 = MFMA32(kb[d0][1], qr[d0], p1); }
}
DI float at_softmax(f32x16& p0, f32x16& p1, float& m_run, bool first, bool nearb, LAS const float* tabp, int lane) {
    if (nearb) {
#pragma unroll
        for (int i = 0; i < 16; ++i) { p0[i] += tabp[8 * (i >> 2) + (i & 3)]; p1[i] += tabp[32 + 8 * (i >> 2) + (i & 3)]; }
    }
    float mx = p0[0];
#pragma unroll
    for (int i = 1; i < 16; ++i) mx = fmaxf(mx, p0[i]);
#pragma unroll
    for (int i = 0; i < 16; ++i) mx = fmaxf(mx, p1[i]);
    float alpha = 1.f;
    if (first || !__all(mx <= AT_THR)) {
        mx = max_x32(mx, lane);
        const float dl = first ? mx : fmaxf(mx, 0.f);
        alpha = first ? 1.f : __builtin_amdgcn_exp2f(-dl); m_run += dl;
#pragma unroll
        for (int i = 0; i < 16; ++i) { p0[i] -= dl; p1[i] -= dl; }
    }
#pragma unroll
    for (int i = 0; i < 16; ++i) p0[i] = __builtin_amdgcn_exp2f(p0[i]);
#pragma unroll
    for (int i = 0; i < 16; ++i) p1[i] = __builtin_amdgcn_exp2f(p1[i]);
    return alpha;
}
DI bf16x8 at_pack(const f32x16& p, int s8) {
    u32x4 w; w.x = at_cvtpk(p[s8], p[s8 + 1]); w.y = at_cvtpk(p[s8 + 2], p[s8 + 3]); w.z = at_cvtpk(p[s8 + 4], p[s8 + 5]); w.w = at_cvtpk(p[s8 + 6], p[s8 + 7]);
    return __builtin_bit_cast(bf16x8, w);
}
template <int D0> DI void at_pv_block(f32x16 (&o)[4], int vb, const bf16x8 (&pf)[4]) {
    const s16x4 l0 = at_tr_read<D0 * 512 + 0 * 4096>(vb), h0 = at_tr_read<D0 * 512 + 0 * 4096 + 2048>(vb), l1 = at_tr_read<D0 * 512 + 1 * 4096>(vb), h1 = at_tr_read<D0 * 512 + 1 * 4096 + 2048>(vb);
    const s16x4 l2 = at_tr_read<D0 * 512 + 2 * 4096>(vb), h2 = at_tr_read<D0 * 512 + 2 * 4096 + 2048>(vb), l3 = at_tr_read<D0 * 512 + 3 * 4096>(vb), h3 = at_tr_read<D0 * 512 + 3 * 4096 + 2048>(vb);
    asm volatile("s_waitcnt lgkmcnt(0)" ::: "memory"); __builtin_amdgcn_sched_barrier(0);
#define AT_PK(L, H) (bf16x8){L[0], L[1], L[2], L[3], H[0], H[1], H[2], H[3]}
    o[D0] = MFMA32(AT_PK(l0, h0), pf[0], o[D0]); o[D0] = MFMA32(AT_PK(l1, h1), pf[1], o[D0]); o[D0] = MFMA32(AT_PK(l2, h2), pf[2], o[D0]); o[D0] = MFMA32(AT_PK(l3, h3), pf[3], o[D0]);
#undef AT_PK
}

DI void at_store_rows8(const unsigned (&pk)[4][4], LAS unsigned char* wst, unsigned char* out_row0, int r32, int hi, int lane) {
#pragma unroll
    for (int d0 = 0; d0 < 4; ++d0)
#pragma unroll
        for (int gq = 0; gq < 4; ++gq) *(LAS unsigned*)(wst + r32 * 144 + 32 * d0 + 8 * gq + 4 * hi) = pk[d0][gq];
    LDS_WAIT();
#pragma unroll
    for (int k = 0; k < 4; ++k) { const int idx = k * 64 + lane, row = idx >> 3, c = idx & 7;
        const u32x4 v = *(const LAS u32x4*)(wst + row * 144 + c * 16);
        *(u32x4*)(out_row0 + (size_t)row * D + c * 16) = v; }
}
DI void at_store_rows(const u32x2 (&pk)[4][4], LAS unsigned char* wst, bf16_t* out_row0  , int r32, int hi, int lane) {
#pragma unroll
    for (int d0 = 0; d0 < 4; ++d0)
#pragma unroll
        for (int gq = 0; gq < 4; ++gq) *(LAS u32x2*)(wst + r32 * 272 + (32 * d0 + 8 * gq + 4 * hi) * 2) = pk[d0][gq];
    LDS_WAIT();
#pragma unroll
    for (int k = 0; k < 8; ++k) { const int idx = k * 64 + lane, row = idx >> 4, c = idx & 15;
        const u32x4 v = *(const LAS u32x4*)(wst + row * 272 + c * 16);
        *(u32x4*)(out_row0 + (size_t)row * D + c * 8) = v; }
}
DI void at_stage1(LAS unsigned char* lds, const char* projb, int kcolB, int vcolB, int kt, int slot, int wid, unsigned lb0, unsigned lb1) {
    const int kv = wid >> 2, sub0 = (wid & 3) * 4;
    LAS unsigned char* dst = lds + slot * 32768 + kv * 16384 + sub0 * 1024;
    const char* tb = projb + (size_t)kt * 64 * (INW * 2) + (kv ? vcolB : kcolB);
#pragma unroll
    for (int n = 0; n < 4; ++n) { const int sub = sub0 + n;
        const size_t U = kv ? (size_t)((sub >> 1) * 8) * (INW * 2) + (size_t)((sub & 1) * 128) : (size_t)(sub * 4) * (INW * 2);
        __builtin_amdgcn_global_load_lds((const unsigned*)(tb + U + ((n & 1) ? lb1 : lb0)), (LAS unsigned*)(dst + n * 1024), 16, 0, 0); }
}
DI void attn_unit_diff(const Ctx& C, int l, int b, int h, int j) {
    constexpr int KS = 4;
    int lane_ = C.lane; asm volatile("" : "+v"(lane_));
    const int lane = lane_, wid = C.wave, g = wid >> 2, wq = wid & 3, r32 = lane & 31, hi = lane >> 5;
    const int qcol = 3072 + h * 128 + g * 64, kcolB = (4096 + h * 128) * 2, vcolB = (5120 + h * 128) * 2;
    const bf16_t* proj = WSP(bf16_t, WS_PROJ);
    const size_t rowb = (size_t)b * SEQ;
    const char* projb = (const char*)(proj + rowb * INW);
    const int nt = 2 * j + 2;
    const int cw = 2 * j + (wq >> 1), q0w = j * 128 + wq * 32, qpos = q0w + r32;
    const float* tabg = WSP(float, WS_TABB) + h * TABB_N;
    LAS float* tabl = (LAS float*)(C.lds + 131072);
    AT_BAR();
    for (int i = wid * 64 + lane; i < TABB_N; i += NTHREADS) tabl[i] = tabg[i];
    bf16x8 qr[8];
    { const bf16_t* qp = proj + (rowb + qpos) * INW + qcol + 8 * hi;
#pragma unroll
      for (int s = 0; s < KS; ++s) qr[s] = *(const bf16x8*)(qp + 16 * s); }
    unsigned lb0, lb1;
    { const int kv = wid >> 2;
      if (kv == 0) { const int rl = lane >> 4, cp = lane & 15; lb0 = (unsigned)(rl * (INW * 2) + ((cp ^ (rl & 7)) * 16)); lb1 = (unsigned)(rl * (INW * 2) + ((cp ^ ((4 + rl) & 7)) * 16)); }
      else { lb0 = (unsigned)(((lane & 31) >> 2) * (INW * 2) + ((lane >> 5) * 32 + (lane & 3) * 8) * 2); lb1 = lb0; } }
    at_stage1(C.lds, projb, kcolB, vcolB, 0, 0, wid, lb0, lb1);
    at_stage1(C.lds, projb, kcolB, vcolB, 1, 1, wid, lb0, lb1);
    f32x16 o[4], ol = {}; float m_run = 0.f; bool first = true;
#pragma unroll
    for (int d0 = 0; d0 < 4; ++d0) o[d0] = f32x16{};
    const bf16x8 ones = {16256, 16256, 16256, 16256, 16256, 16256, 16256, 16256};
    asm volatile("s_waitcnt vmcnt(4) lgkmcnt(0)\n\ts_barrier" ::: "memory");
    const float cfar = tabl[0];
    const int vrd = at_v_rd_base(lane);
    for (int sd = 0; sd < nt; ++sd) {
        const int slot = sd % 3;
        const bool staged = sd + 2 < nt;
        if (staged) at_stage1(C.lds, projb, kcolB, vcolB, sd + 2, (sd + 2) % 3, wid, lb0, lb1);
        if (sd <= cw) {
            LAS const unsigned char* Kt = C.lds + slot * 32768;
            const int vb = (int)(size_t)(Kt + 16384) + vrd;
            const bool nearb = (sd * 64 + 63 - q0w) > -305;
            LAS const float* tabp = tabl + (sd * 64 - qpos + TABB_OFF + 4 * hi);
            f32x16 p0, p1;
            at_qk<KS>(p0, p1, Kt, g * 128, qr, (nearb ? 0.f : cfar) - m_run, r32, hi);
            const float alpha = at_softmax(p0, p1, m_run, first, nearb, tabp, lane);
            first = false;
            if (__any(alpha != 1.f)) {
                ol[0] *= alpha;
#pragma unroll
                for (int d0 = 0; d0 < 4; ++d0)
#pragma unroll
                    for (int i = 0; i < 16; ++i) o[d0][i] *= alpha;
            }
            bf16x8 pf[4];
            pf[0] = at_pack(p0, 0); pf[1] = at_pack(p0, 8); pf[2] = at_pack(p1, 0); pf[3] = at_pack(p1, 8);
            ol = MFMA32(ones, pf[0], ol); ol = MFMA32(ones, pf[1], ol); ol = MFMA32(ones, pf[2], ol); ol = MFMA32(ones, pf[3], ol);
            at_pv_block<0>(o, vb, pf); at_pv_block<1>(o, vb, pf); at_pv_block<2>(o, vb, pf); at_pv_block<3>(o, vb, pf);
        }
        if (staged) asm volatile("s_waitcnt vmcnt(4) lgkmcnt(0)\n\ts_barrier" ::: "memory");
        else        asm volatile("s_waitcnt vmcnt(0) lgkmcnt(0)\n\ts_barrier" ::: "memory");
    }
    const float inv = 1.f / ol[0];
    LAS float* cmb = (LAS float*)C.lds + (size_t)wq * (64 * 64);
    if (g == 1) {
#pragma unroll
        for (int d0 = 0; d0 < 4; ++d0)
#pragma unroll
            for (int i = 0; i < 16; ++i) cmb[(d0 * 16 + i) * 64 + lane] = o[d0][i] * inv;
    }
    AT_BAR();
    if (g == 0) {
        const float lam = WSP(float, WS_LAM)[l]; float ss = 0.f;
#pragma unroll
        for (int d0 = 0; d0 < 4; ++d0)
#pragma unroll
            for (int i = 0; i < 16; ++i) { const float v = o[d0][i] * inv - lam * cmb[(d0 * 16 + i) * 64 + lane]; o[d0][i] = v; ss += v * v; }
        ss = sum_x32(ss, lane);
        const float lam_init = 0.8f - 0.6f * expf(-0.3f * (float)l);
        const float rn = rsqrtf(ss * (1.f / 128.f) + EPS) * (1.f - lam_init);
        const float* sg = CIN(I_SUBLN) + l * 128;
        if (l >= L8B) { unsigned pk8v[4][4];
#pragma unroll
            for (int d0 = 0; d0 < 4; ++d0)
#pragma unroll
                for (int gq = 0; gq < 4; ++gq) { const int d = 32 * d0 + 8 * gq + 4 * hi; const f32x4 gv = *(const f32x4*)(sg + d);
                    pk8v[d0][gq] = pk8(clamp8(o[d0][4 * gq] * rn * gv.x), clamp8(o[d0][4 * gq + 1] * rn * gv.y), clamp8(o[d0][4 * gq + 2] * rn * gv.z), clamp8(o[d0][4 * gq + 3] * rn * gv.w)); }
            at_store_rows8(pk8v, C.lds + 65536 + wq * 8704, WSP(unsigned char, WS_MIX) + (rowb + q0w) * D + 1024 + h * 128, r32, hi, lane);
        } else {
        u32x2 pk[4][4];
#pragma unroll
        for (int d0 = 0; d0 < 4; ++d0)
#pragma unroll
            for (int gq = 0; gq < 4; ++gq) { const int d = 32 * d0 + 8 * gq + 4 * hi; const f32x4 gv = *(const f32x4*)(sg + d);
                pk[d0][gq].x = at_cvtpk(o[d0][4 * gq] * rn * gv.x, o[d0][4 * gq + 1] * rn * gv.y); pk[d0][gq].y = at_cvtpk(o[d0][4 * gq + 2] * rn * gv.z, o[d0][4 * gq + 3] * rn * gv.w); }
        at_store_rows(pk, C.lds + 65536 + wq * 8704, WSP(bf16_t, WS_MIX) + (rowb + q0w) * D + 1024 + h * 128, r32, hi, lane); }
    }
}
DI void attn_unit_band(const Ctx& C, int l, int b, int h, int qt) {
    constexpr int KS = 8;
    int lane_ = C.lane; asm volatile("" : "+v"(lane_));
    const int lane = lane_, wid = C.wave, r32 = lane & 31, hi = lane >> 5;
    const int qcol = h * 128, kcolB = (1024 + h * 128) * 2, vcolB = (2048 + h * 128) * 2;
    const bf16_t* proj = WSP(bf16_t, WS_PROJ);
    const size_t rowb = (size_t)b * SEQ;
    const char* projb = (const char*)(proj + rowb * INW);
    const int kt_hi = 4 * qt + 3, kt_lo = qt >= 2 ? 4 * qt - 8 : 0, nt = kt_hi - kt_lo + 1;
    const int cw = 4 * qt + (wid >> 1), q0w = qt * 256 + wid * 32, qpos = q0w + r32;
    const float* tabg = WSP(float, WS_TABA) + (l * 8 + h) * TABA_N;
    LAS float* tabl = (LAS float*)(C.lds + 131072);
    AT_BAR();
    for (int i = wid * 64 + lane; i < TABA_N; i += NTHREADS) tabl[i] = tabg[i];
    bf16x8 qr[8];
    { const bf16_t* qp = proj + (rowb + qpos) * INW + qcol + 8 * hi;
#pragma unroll
      for (int s = 0; s < KS; ++s) qr[s] = *(const bf16x8*)(qp + 16 * s); }
    unsigned lb0, lb1;
    { const int kv = wid >> 2;
      if (kv == 0) { const int rl = lane >> 4, cp = lane & 15; lb0 = (unsigned)(rl * (INW * 2) + ((cp ^ (rl & 7)) * 16)); lb1 = (unsigned)(rl * (INW * 2) + ((cp ^ ((4 + rl) & 7)) * 16)); }
      else { lb0 = (unsigned)(((lane & 31) >> 2) * (INW * 2) + ((lane >> 5) * 32 + (lane & 3) * 8) * 2); lb1 = lb0; } }
    at_stage1(C.lds, projb, kcolB, vcolB, kt_lo, 0, wid, lb0, lb1);
    at_stage1(C.lds, projb, kcolB, vcolB, kt_lo + 1, 1, wid, lb0, lb1);
    f32x16 o[4], ol = {}; float m_run = 0.f; bool first = true;
#pragma unroll
    for (int d0 = 0; d0 < 4; ++d0) o[d0] = f32x16{};
    const bf16x8 ones = {16256, 16256, 16256, 16256, 16256, 16256, 16256, 16256};
    asm volatile("s_waitcnt vmcnt(4) lgkmcnt(0)\n\ts_barrier" ::: "memory");
    const float cfar = tabl[0];
    const int vrd = at_v_rd_base(lane);
    for (int sd = 0; sd < nt; ++sd) {
        const int slot = sd % 3, kt = kt_lo + sd;
        const bool staged = sd + 2 < nt;
        if (staged) at_stage1(C.lds, projb, kcolB, vcolB, kt + 2, (sd + 2) % 3, wid, lb0, lb1);
        if (kt <= cw && kt >= cw - 8) {
            LAS const unsigned char* Kt = C.lds + slot * 32768;
            const int vb = (int)(size_t)(Kt + 16384) + vrd;
            const bool nearb = (kt * 64 + 63 - q0w) > -128;
            LAS const float* tabp = tabl + (kt * 64 - qpos + TABA_OFF + 4 * hi);
            f32x16 p0, p1;
            at_qk<KS>(p0, p1, Kt, 0, qr, (nearb ? 0.f : cfar) - m_run, r32, hi);
            const float alpha = at_softmax(p0, p1, m_run, first, nearb, tabp, lane);
            first = false;
            if (__any(alpha != 1.f)) {
                ol[0] *= alpha;
#pragma unroll
                for (int d0 = 0; d0 < 4; ++d0)
#pragma unroll
                    for (int i = 0; i < 16; ++i) o[d0][i] *= alpha;
            }
            bf16x8 pf[4];
            pf[0] = at_pack(p0, 0); pf[1] = at_pack(p0, 8); pf[2] = at_pack(p1, 0); pf[3] = at_pack(p1, 8);
            ol = MFMA32(ones, pf[0], ol); ol = MFMA32(ones, pf[1], ol); ol = MFMA32(ones, pf[2], ol); ol = MFMA32(ones, pf[3], ol);
            at_pv_block<0>(o, vb, pf); at_pv_block<1>(o, vb, pf); at_pv_block<2>(o, vb, pf); at_pv_block<3>(o, vb, pf);
        }
        if (staged) asm volatile("s_waitcnt vmcnt(4) lgkmcnt(0)\n\ts_barrier" ::: "memory");
        else        asm volatile("s_waitcnt vmcnt(0) lgkmcnt(0)\n\ts_barrier" ::: "memory");
    }
    const float inv = 1.f / ol[0];
    if (l >= L8B) { unsigned pk8v[4][4];
#pragma unroll
        for (int d0 = 0; d0 < 4; ++d0)
#pragma unroll
            for (int gq = 0; gq < 4; ++gq) pk8v[d0][gq] = pk8(clamp8(o[d0][4 * gq] * inv), clamp8(o[d0][4 * gq + 1] * inv), clamp8(o[d0][4 * gq + 2] * inv), clamp8(o[d0][4 * gq + 3] * inv));
        at_store_rows8(pk8v, C.lds + wid * 8704, WSP(unsigned char, WS_MIX) + (rowb + q0w) * D + h * 128, r32, hi, lane);
    } else {
    u32x2 pk[4][4];
#pragma unroll
    for (int d0 = 0; d0 < 4; ++d0)
#pragma unroll
        for (int gq = 0; gq < 4; ++gq) { pk[d0][gq].x = at_cvtpk(o[d0][4 * gq] * inv, o[d0][4 * gq + 1] * inv); pk[d0][gq].y = at_cvtpk(o[d0][4 * gq + 2] * inv, o[d0][4 * gq + 3] * inv); }
    at_store_rows(pk, C.lds + wid * 8704, WSP(bf16_t, WS_MIX) + (rowb + q0w) * D + h * 128, r32, hi, lane); }
}
DI void phase_attn(const Ctx& C, int l) {
    const int G = (int)gridDim.x, cb = (int)blockIdx.x;
    const int vc = (G == 256) ? ((cb & 7) * 32 + (cb >> 3)) : cb;
    for (int pc = vc; pc < 256; pc += G) { const int bh = pc >> 4, jp = pc & 15;
        attn_unit_diff(C, l, bh >> 3, bh & 7, 31 - jp); attn_unit_diff(C, l, bh >> 3, bh & 7, jp); }
    for (int ia = vc; ia < 256; ia += G) { const int bh = ia >> 4; attn_unit_band(C, l, bh >> 3, bh & 7, ia & 15); }
    AT_BAR();
}

namespace pg8 {
constexpr int BM = 256, BK = 64, HALF = 128, HTB = HALF * BK * 2, STAGE_BYTES = 8 * HTB;
__host__ __device__ __forceinline__ int lds_byte(int r, int c) { const int st = (r >> 4) * 2 + (c >> 5), rr = r & 15, cc = c & 31, ob = rr * 64 + cc * 2; return st * 1024 + (ob ^ (((ob >> 9) & 1) << 5)); }
__host__ __device__ __forceinline__ void stage_rc(int b, int& R, int& C) { const int st = b / 1024, sb = b % 1024, swz = sb ^ (((sb >> 9) & 1) << 5); R = (st >> 1) * 16 + swz / 64; C = (st & 1) * 32 + (swz % 64) / 2; }
__host__ __device__ __forceinline__ int perm32(int rho) { const int n = rho >> 4, i = rho & 15; return 8 * (i >> 2) + 4 * n + (i & 3); }
struct Unit { const char* A; const char* B; int pm, pn, z, n, base; };
__device__ __forceinline__ unsigned cvt_pk_bf16(float lo, float hi) { unsigned r; asm volatile("v_cvt_pk_bf16_f32 %0, %1, %2" : "=v"(r) : "v"(lo), "v"(hi)); return r; }

template <class Epi, class Sched, bool ALIGN_EPI, bool GATHER = false, bool F8 = false>
__device__ __forceinline__ void gemm_phase(LAS unsigned char* lds, const int tid, const int lda, const int ldb, const int K, const Sched& S, const Epi& E) {
    const int wid = __builtin_amdgcn_readfirstlane(tid >> 6), lane = tid & 63, wr = wid >> 2, wc = wid & 3, fr = lane & 15, fq = lane >> 4;
    const int nt = K / BK;
    unsigned voffA[2], voffB[2];
#pragma unroll
    for (int i = 0; i < 2; ++i) { int R, C; stage_rc(tid * 16 + i * 8192, R, C); const int Rb = (R & ~31) + perm32(R & 31);
        voffA[i] = (unsigned)(R * lda + C) * 2u; voffB[i] = (unsigned)(Rb * ldb + C) * 2u; }
    const size_t kstep = (size_t)(BK * 2);
    const size_t hstepA = GATHER ? (size_t)0 : (size_t)HALF * lda * 2, hstepB = (size_t)HALF * ldb * 2;
    unsigned cvo[2][2];
    const unsigned ldsw = (unsigned)wid * 1024u;
    const int aoff = lds_byte(wr * 64 + fr, fq * 8), boff = lds_byte(wc * 32 + fr, fq * 8);
#define PG8_SA(b, h) (((b) * 2 + (h)) * HTB)
#define PG8_SB(b, h) ((4 + (b) * 2 + (h)) * HTB)
#define PG8_STAGE(bufoff, gbase, voff) do { _Pragma("unroll") for (int _i = 0; _i < 2; ++_i) \
        __builtin_amdgcn_global_load_lds((const unsigned*)((const char*)(gbase) + (voff)[_i]), (LAS unsigned*)(lds + (bufoff) + ldsw + _i * 8192), 16, 0, 0); } while (0)
#define PG8_STAGE_A(bufoff, gbase, hh, vo) do { if constexpr (GATHER) { PG8_STAGE(bufoff, gbase, (vo)[hh]); } else { PG8_STAGE(bufoff, (gbase) + (hh) * hstepA, voffA); } } while (0)
#define PG8_GOFFS(u, vo) do { if constexpr (GATHER) { const int* _ix = S.idx(u); _Pragma("unroll") for (int _h = 0; _h < 2; ++_h) _Pragma("unroll") for (int _i = 0; _i < 2; ++_i) { int _gR, _gC; stage_rc(tid * 16 + _i * 8192, _gR, _gC); const int _r = (u).pm * BM + _h * HALF + _gR; \
        const int _tk = _ix[_r < (u).n ? _r : 0] >> 1; const int _tok = _r < (u).n ? _tk : 0; (vo)[_h][_i] = (unsigned)(_tok * lda + _gC) * 2u; } } } while (0)
#define PG8_LD8(p) __builtin_shufflevector(*(const LAS i32x4*)(p), *(const LAS i32x4*)((p) + 1024), 0, 1, 2, 3, 4, 5, 6, 7)
#define PG8_LDA(dst, b, h) do { if constexpr (F8) { _Pragma("unroll") for (int m = 0; m < 4; ++m) dst##8[m] = PG8_LD8(lds + PG8_SA(b, h) + aoff + m * 2048); } \
      else { _Pragma("unroll") for (int m = 0; m < 4; ++m) _Pragma("unroll") for (int k = 0; k < 2; ++k) dst[m][k] = *(const LAS bf16x8*)(lds + PG8_SA(b, h) + aoff + m * 2048 + k * 1024); } } while (0)
#define PG8_LDB(dst, b, h) do { if constexpr (F8) { _Pragma("unroll") for (int n = 0; n < 2; ++n) dst##8[n] = PG8_LD8(lds + PG8_SB(b, h) + boff + n * 2048); } \
      else { _Pragma("unroll") for (int n = 0; n < 2; ++n) _Pragma("unroll") for (int k = 0; k < 2; ++k) dst[n][k] = *(const LAS bf16x8*)(lds + PG8_SB(b, h) + boff + n * 2048 + k * 1024); } } while (0)
#define PG8_MMA(ai, bj, At, Bt) do { __builtin_amdgcn_s_setprio(1); if constexpr (F8) { _Pragma("unroll") for (int m = 0; m < 4; ++m) _Pragma("unroll") for (int n = 0; n < 2; ++n) \
        asm volatile("v_mfma_f32_16x16x128_f8f6f4 %0, %1, %2, %0" : "+v"(acc[ai][bj][m][n]) : "v"(Bt##8[n]), "v"(At##8[m])); } \
      else { _Pragma("unroll") for (int m = 0; m < 4; ++m) _Pragma("unroll") for (int n = 0; n < 2; ++n) _Pragma("unroll") for (int k = 0; k < 2; ++k) \
        acc[ai][bj][m][n] = __builtin_amdgcn_mfma_f32_16x16x32_bf16(Bt[n][k], At[m][k], acc[ai][bj][m][n], 0, 0, 0); } __builtin_amdgcn_s_setprio(0); } while (0)
#define PG8_WAIT_V(n) asm volatile("s_waitcnt vmcnt(" #n ")" ::: "memory")
#define PG8_WAIT_L(n) asm volatile("s_waitcnt lgkmcnt(" #n ")" ::: "memory")
#define PG8_BAR __builtin_amdgcn_s_barrier()
#define PG8_SCHED __builtin_amdgcn_sched_barrier(0)
    Unit cur, nxt; int ui = 0;
    if (!S.next(0, cur)) return;
    f32x4 acc[2][2][4][2];
    int evp[2][4];
    if constexpr (Epi::HAS_PREFI) { E.pref_load_i(evp, cur, wr, fr); __builtin_amdgcn_sched_barrier(0); }
    u32x4 oldv[2][4][2];
    if constexpr (Epi::HAS_INIT) { E.init_load(oldv, cur, wr, wc, fr, fq); __builtin_amdgcn_sched_barrier(0); }
    else {
#pragma unroll
    for (int a = 0; a < 2; ++a)
#pragma unroll
        for (int b = 0; b < 2; ++b)
#pragma unroll
            for (int m = 0; m < 4; ++m)
#pragma unroll
                for (int n = 0; n < 2; ++n) acc[a][b][m][n] = (f32x4){0.f, 0.f, 0.f, 0.f};
    }
    bf16x8 At[4][2], B0[2][2], B1[2][2]; i32x8 At8[4], B08[2], B18[2];
    const char* cA = cur.A; const char* cB = cur.B;
    PG8_GOFFS(cur, cvo);
    PG8_STAGE(PG8_SB(0, 0), cB, voffB); PG8_STAGE(PG8_SB(0, 1), cB + hstepB, voffB); PG8_STAGE_A(PG8_SA(0, 0), cA, 0, cvo); PG8_STAGE_A(PG8_SA(0, 1), cA, 1, cvo);
    if (wr == 1) PG8_BAR;
    PG8_WAIT_V(2); PG8_BAR;
    if constexpr (Epi::HAS_INIT) { E.init_finish(acc, oldv); __builtin_amdgcn_sched_barrier(0); }
    PG8_STAGE(PG8_SB(1, 0), cB + kstep, voffB); PG8_STAGE_A(PG8_SA(1, 0), cA + kstep, 0, cvo); PG8_STAGE(PG8_SB(1, 1), cB + hstepB + kstep, voffB);
    PG8_WAIT_V(6); PG8_BAR;
    for (;;) {
        const bool has_next = S.next(ui + 1, nxt);
        const char* nA = has_next ? nxt.A : cA; const char* nB = has_next ? nxt.B : cB;
#pragma nounroll
        for (int t = 0; t < nt; t += 2) {
            const bool last = (t == nt - 2);
            if constexpr (GATHER) asm volatile("" : "+v"(cvo[0][0]), "+v"(cvo[0][1]), "+v"(cvo[1][0]), "+v"(cvo[1][1]));
            asm volatile("" : "+v"(voffA[0]), "+v"(voffA[1]), "+v"(voffB[0]), "+v"(voffB[1]));
            const char* a1 = cA + (size_t)(t + 1) * kstep;
            const char* a2 = last ? nA : cA + (size_t)(t + 2) * kstep; const char* b2 = last ? nB : cB + (size_t)(t + 2) * kstep;
            const char* a3 = a2 + kstep; const char* b3 = b2 + kstep;
            PG8_LDB(B0, 0, 0); PG8_LDB(B1, 0, 1); PG8_SCHED; PG8_LDA(At, 0, 0); PG8_STAGE_A(PG8_SA(1, 1), a1, 1, cvo);
            if constexpr (GATHER) { if (last && has_next) { PG8_GOFFS(nxt, cvo); } }
            PG8_WAIT_V(8); PG8_WAIT_L(0); PG8_BAR; PG8_MMA(0, 0, At, B0); PG8_MMA(0, 1, At, B1); PG8_BAR; PG8_SCHED;
            PG8_LDA(At, 0, 1); PG8_STAGE(PG8_SB(0, 0), b2, voffB); PG8_STAGE(PG8_SB(0, 1), b2 + hstepB, voffB); PG8_STAGE_A(PG8_SA(0, 0), a2, 0, cvo);
            PG8_WAIT_V(8); PG8_WAIT_L(0); PG8_BAR; PG8_MMA(1, 0, At, B0); PG8_MMA(1, 1, At, B1); PG8_BAR; PG8_SCHED;
            PG8_LDB(B0, 1, 0); PG8_LDB(B1, 1, 1); PG8_SCHED; PG8_LDA(At, 1, 0); PG8_STAGE_A(PG8_SA(0, 1), a2, 1, cvo);
            PG8_WAIT_V(8); PG8_WAIT_L(0); PG8_BAR; PG8_MMA(0, 0, At, B0); PG8_MMA(0, 1, At, B1); PG8_BAR; PG8_SCHED;
            PG8_LDA(At, 1, 1); PG8_STAGE(PG8_SB(1, 0), b3, voffB); PG8_STAGE(PG8_SB(1, 1), b3 + hstepB, voffB); PG8_STAGE_A(PG8_SA(1, 0), a3, 0, cvo);
            PG8_WAIT_V(8); PG8_WAIT_L(0); PG8_BAR; PG8_MMA(1, 0, At, B0); PG8_MMA(1, 1, At, B1); PG8_BAR; PG8_SCHED;
        }
        if constexpr (ALIGN_EPI) { if (wr == 0) PG8_BAR; }
        if constexpr (F8) asm volatile("s_nop 15\n\ts_nop 15" ::: "memory");
        if constexpr (!Epi::AFTER_DRAIN) { unsigned z_ = 0u; asm volatile("" : "+s"(z_)); const int l_ = (int)__builtin_amdgcn_mbcnt_hi(~0u, __builtin_amdgcn_mbcnt_lo(~0u, z_));
            if constexpr (Epi::HAS_PREFI) E.run_pref_i(acc, cur, wr, wc, l_ & 15, l_ >> 4, evp, has_next, nxt); else E(acc, cur, wr, wc, l_ & 15, l_ >> 4); }
        if (!has_next) break;
        if constexpr (Epi::HAS_INIT) { unsigned z2_ = 0u; asm volatile("" : "+s"(z2_)); const int l2_ = (int)__builtin_amdgcn_mbcnt_hi(~0u, __builtin_amdgcn_mbcnt_lo(~0u, z2_)); E.init(acc, nxt, wr, wc, l2_ & 15, l2_ >> 4); }
        else {
#pragma unroll
        for (int a = 0; a < 2; ++a)
#pragma unroll
            for (int b = 0; b < 2; ++b)
#pragma unroll
                for (int m = 0; m < 4; ++m)
#pragma unroll
                    for (int n = 0; n < 2; ++n) acc[a][b][m][n] = (f32x4){0.f, 0.f, 0.f, 0.f};
        }
        cur = nxt; cA = nA; cB = nB; ++ui;
        if constexpr (ALIGN_EPI) { if (wr == 1) PG8_BAR; }
    }
    PG8_WAIT_V(0);
    if constexpr (!ALIGN_EPI) { if (wr == 0) PG8_BAR; }
    PG8_BAR;
    if constexpr (F8 && Epi::AFTER_DRAIN) asm volatile("s_nop 15\n\ts_nop 15" ::: "memory");
    if constexpr (Epi::AFTER_DRAIN) { unsigned z_ = 0u; asm volatile("" : "+s"(z_)); const int l_ = (int)__builtin_amdgcn_mbcnt_hi(~0u, __builtin_amdgcn_mbcnt_lo(~0u, z_));
        E.fused(acc, cur, wr, wc, l_ & 15, l_ >> 4, lds, wid, l_); }
#undef PG8_SA
#undef PG8_SB
#undef PG8_STAGE
#undef PG8_STAGE_A
#undef PG8_GOFFS
#undef PG8_LDA
#undef PG8_LDB
#undef PG8_MMA
#undef PG8_LD8
#undef PG8_WAIT_V
#undef PG8_WAIT_L
#undef PG8_BAR
#undef PG8_SCHED
}

struct DenseOrder {
    const char* A; const char* B; int lda, ldb, nM, nN, nwg, G, c;
    __device__ __forceinline__ void init(const void* A_, const void* B_, int lda_, int ldb_, int M, int N, int G_, int c_) { A = (const char*)A_; B = (const char*)B_; lda = lda_; ldb = ldb_; nM = M / BM; nN = N / BM; nwg = nM * nN; G = G_; c = c_; }
    __device__ __forceinline__ bool next(int i, Unit& u) const {
        const long L = (long)i * G + c; if (L >= nwg) return false;
        int wgid = (int)L; { const int q = nwg / 8, r = nwg % 8, xcd = wgid % 8, off = wgid / 8; wgid = (xcd < r ? xcd * (q + 1) : r * (q + 1) + (xcd - r) * q) + off; }
        const int nig = 8 * nN, gid = wgid / nig, fm = gid * 8, gsz = (nM - fm) < 8 ? (nM - fm) : 8;
        u.pm = fm + ((wgid % nig) % gsz); u.pn = (wgid % nig) / gsz; u.z = 0; u.n = 0; u.base = 0;
        u.A = A + (size_t)u.pm * BM * lda * 2; u.B = B + (size_t)u.pn * BM * ldb * 2; return true;
    }
};
struct MaskOrder {
    const char* A; const char* B; int lda, ldb, nM, nN, nwg, G, c; unsigned mask;
    __device__ __forceinline__ void init(const void* A_, const void* B_, int lda_, int ldb_, int M, unsigned mask_, int G_, int c_) { A = (const char*)A_; B = (const char*)B_; lda = lda_; ldb = ldb_; nM = M / BM; mask = mask_; nN = __builtin_popcount(mask_); nwg = nM * nN; G = G_; c = c_; }
    __device__ __forceinline__ bool next(int i, Unit& u) const {
        const long L = (long)i * G + c; if (L >= nwg) return false;
        int wgid = (int)L; { const int q = nwg / 8, r = nwg % 8, xcd = wgid % 8, off = wgid / 8; wgid = (xcd < r ? xcd * (q + 1) : r * (q + 1) + (xcd - r) * q) + off; }
        const int nig = 8 * nN, gid = wgid / nig, fm = gid * 8, gsz = (nM - fm) < 8 ? (nM - fm) : 8;
        u.pm = fm + ((wgid % nig) % gsz); int k = (wgid % nig) / gsz, pn = 0;
        for (int b = 0; b < 32; ++b) if ((mask >> b) & 1u) { if (k == 0) { pn = b; break; } --k; }
        u.pn = pn; u.z = 0; u.n = 0; u.base = 0;
        u.A = A + (size_t)u.pm * BM * lda * 2; u.B = B + (size_t)u.pn * BM * ldb * 2; return true;
    }
};
struct MultiOrder {
    const char* A; const char* B; size_t a1, a2, a3, b1, b2, b3; int zs, zm, zs3, nM, nN, nz, lda, ldb, G, c;
    __device__ __forceinline__ bool next(int i, Unit& u) const {
        const long L = (long)i * G + c; const int per = nM * nN; if (L >= (long)per * nz) return false;
        const int z = (int)(L / per), r = (int)(L % per);
        u.pm = r / nN; u.pn = r % nN; u.z = z; u.n = 0; u.base = 0;
        u.A = A + (size_t)(z >> zs) * a1 + (size_t)(z & zm) * a2 + (size_t)(z >> zs3) * a3 + (size_t)u.pm * BM * lda * 2;
        u.B = B + (size_t)(z >> zs) * b1 + (size_t)(z & zm) * b2 + (size_t)(z >> zs3) * b3 + (size_t)u.pn * BM * ldb * 2; return true;
    }
};

__device__ __forceinline__ void rowscale4(const float* part, size_t rowb, int fq, int lane, float (&sc)[4]) {
    f32x4 a[4], b[4];
#pragma unroll
    for (int m = 0; m < 4; ++m) { const f32x4* p = (const f32x4*)(part + (rowb + 16 * m) * 32 + fq * 8); a[m] = p[0]; b[m] = p[1]; }
#pragma unroll
    for (int m = 0; m < 4; ++m) { float s = ((a[m].x + a[m].y) + (a[m].z + a[m].w)) + ((b[m].x + b[m].y) + (b[m].z + b[m].w));
        s = sum_x32(sum_x16(s, lane), lane); sc[m] = rsqrtf(s * (1.f / D) + EPS); }
}
template <int SC, bool INP8 = false, bool V8 = false> struct EpiStore {
    static constexpr bool AFTER_DRAIN = false; static constexpr bool HAS_INIT = false; static constexpr bool HAS_PREFI = false;
    bf16_t* O; size_t o1, o2; int zs, zm, ldc; const float* rv; size_t rvz;
    float s8;
    __device__ __forceinline__ void operator()(const f32x4 (&acc)[2][2][4][2], const Unit& u, int wr, int wc, int fr, int fq) const {
        const int row0 = u.pm * BM + wr * 64 + fr, col0 = u.pn * BM + wc * 32 + 8 * fq;
        bf16_t* base = O + (size_t)(u.z >> zs) * o1 + (size_t)(u.z & zm) * o2;
#pragma unroll
        for (int ai = 0; ai < 2; ++ai) {
            float sc[4] = {1.f, 1.f, 1.f, 1.f};
            if (SC == 1) rowscale4(rv, (size_t)u.z * rvz + row0 + ai * HALF, fq, fr + 16 * fq, sc);
            if constexpr (INP8) { const float cs = (u.pn < 4 ? SC_A : ((u.pn >= 12 && u.pn < 16) ? SC_B : 1.f)) * (1.f / W8S);
#pragma unroll
                for (int m = 0; m < 4; ++m) sc[m] *= cs; }
            if (SC == 2) {
#pragma unroll
                for (int m = 0; m < 4; ++m) sc[m] = rv[(size_t)u.z * rvz + row0 + ai * HALF + m * 16]; }
#pragma unroll
            for (int m = 0; m < 4; ++m) { const int row = row0 + ai * HALF + m * 16;
                bf16_t* rowp = base + (size_t)row * ldc + col0;
                if constexpr (V8) { { unsigned char* rp8 = (unsigned char*)O + (size_t)(u.z >> zs) * o1 + (size_t)(u.z & zm) * o2 + (size_t)row * ldc + col0; const float s8m = sc[m] * s8;
#pragma unroll
                    for (int bj = 0; bj < 2; ++bj) { const f32x4 v0 = acc[ai][bj][m][0] * s8m, v1 = acc[ai][bj][m][1] * s8m;
                        u32x2 w8; w8.x = pk8(clamp8(v0[0]), clamp8(v0[1]), clamp8(v0[2]), clamp8(v0[3])); w8.y = pk8(clamp8(v1[0]), clamp8(v1[1]), clamp8(v1[2]), clamp8(v1[3]));
                        *(u32x2*)(rp8 + bj * HALF) = w8; }
                    continue; } }
#pragma unroll
                for (int bj = 0; bj < 2; ++bj) { const f32x4 v0 = acc[ai][bj][m][0] * sc[m], v1 = acc[ai][bj][m][1] * sc[m];
                    u32x4 w; w.x = cvt_pk_bf16(v0[0], v0[1]); w.y = cvt_pk_bf16(v0[2], v0[3]); w.z = cvt_pk_bf16(v1[0], v1[1]); w.w = cvt_pk_bf16(v1[2], v1[3]);
                    *(u32x4*)(rowp + bj * HALF) = w; } } }
    }
};
struct EpiResidualPart {
    static constexpr bool AFTER_DRAIN = false; static constexpr bool HAS_INIT = true; static constexpr bool HAS_PREFI = false;
    bf16_t* X; float* part; size_t zrows;
    unsigned char* x8;
    float as;
    __device__ __forceinline__ void init_load(u32x4 (&old)[2][4][2], const Unit& u, int wr, int wc, int fr, int fq) const {
        const int row0 = u.pm * BM + wr * 64 + fr, col0 = u.pn * BM + wc * 32 + 8 * fq;
#pragma unroll
        for (int ai = 0; ai < 2; ++ai)
#pragma unroll
            for (int m = 0; m < 4; ++m)
#pragma unroll
                for (int bj = 0; bj < 2; ++bj) old[ai][m][bj] = *(const u32x4*)(X + ((size_t)u.z * zrows + row0 + ai * HALF + m * 16) * D + col0 + bj * HALF);
    }
    __device__ __forceinline__ void init_finish(f32x4 (&acc)[2][2][4][2], const u32x4 (&old)[2][4][2]) const {
        const float ias = 1.f / as;
#pragma unroll
        for (int ai = 0; ai < 2; ++ai)
#pragma unroll
            for (int m = 0; m < 4; ++m)
#pragma unroll
                for (int bj = 0; bj < 2; ++bj)
#pragma unroll
                    for (int q = 0; q < 4; ++q) { acc[ai][bj][m][q >> 1][(q & 1) * 2] = __uint_as_float(old[ai][m][bj][q] << 16) * ias; acc[ai][bj][m][q >> 1][(q & 1) * 2 + 1] = __uint_as_float(old[ai][m][bj][q] & 0xffff0000u) * ias; }
    }
    __device__ __forceinline__ void init(f32x4 (&acc)[2][2][4][2], const Unit& u, int wr, int wc, int fr, int fq) const { u32x4 old[2][4][2]; init_load(old, u, wr, wc, fr, fq); init_finish(acc, old); }
    __device__ __forceinline__ void operator()(const f32x4 (&acc)[2][2][4][2], const Unit& u, int wr, int wc, int fr, int fq) const {
        const int row0 = u.pm * BM + wr * 64 + fr, col0 = u.pn * BM + wc * 32 + 8 * fq, lane = fr + 16 * fq;
#pragma unroll
        for (int ai = 0; ai < 2; ++ai) {
#pragma unroll
            for (int m = 0; m < 4; ++m) { const size_t row = (size_t)u.z * zrows + row0 + ai * HALF + m * 16;
                bf16_t* rowp = X + row * D + col0; float ss = 0.f;
#pragma unroll
                for (int bj = 0; bj < 2; ++bj) { u32x4 w;
#pragma unroll
                    for (int q = 0; q < 4; ++q) { const float lo = acc[ai][bj][m][q >> 1][(q & 1) * 2] * as, hi = acc[ai][bj][m][q >> 1][(q & 1) * 2 + 1] * as;
                        w[q] = cvt_pk_bf16(lo, hi); const float a = __uint_as_float(w[q] << 16), b = __uint_as_float(w[q] & 0xffff0000u); ss += a * a + b * b; }
                    *(u32x4*)(rowp + bj * HALF) = w;
                    if (x8) { u32x2 e;
#pragma unroll
                        for (int h2 = 0; h2 < 2; ++h2) e[h2] = pk8(clamp8(__uint_as_float(w[2 * h2] << 16)), clamp8(__uint_as_float(w[2 * h2] & 0xffff0000u)), clamp8(__uint_as_float(w[2 * h2 + 1] << 16)), clamp8(__uint_as_float(w[2 * h2 + 1] & 0xffff0000u)));
                        *(u32x2*)(x8 + row * D + col0 + bj * HALF) = e; } }
                ss = sum_x32(sum_x16(ss, lane), lane);
                if (fq == 0) part[row * 32 + u.pn * 4 + wc] = ss; } }
    }
};
struct EpiSoftmaxP {
    static constexpr bool AFTER_DRAIN = true; static constexpr bool HAS_INIT = false; static constexpr bool HAS_PREFI = false;
    bf16_t* P; const float* part; int f8; float as;
    __device__ __forceinline__ void fused(f32x4 (&acc)[2][2][4][2], const Unit& u, int wr, int wc, int fr, int fq, LAS unsigned char* lds, int wid, int lane) const {
        LAS float* MX = (LAS float*)lds; LAS float* SM = (LAS float*)(lds + 4096);
        const int row0 = u.pm * BM + wr * 64 + fr, col0 = u.pn * BM + wc * 32 + 8 * fq;
#pragma unroll
        for (int ai = 0; ai < 2; ++ai) {
            float scv[4]; rowscale4(part, (size_t)u.z * SEQ + row0 + ai * HALF, fq, lane, scv);
#pragma unroll
            for (int m = 0; m < 4; ++m) { const float sc = scv[m] * as; float mx = -3.0e38f;
#pragma unroll
                for (int bj = 0; bj < 2; ++bj)
#pragma unroll
                    for (int n = 0; n < 2; ++n) { acc[ai][bj][m][n] = acc[ai][bj][m][n] * sc; const f32x4 v = acc[ai][bj][m][n]; mx = fmaxf(mx, fmaxf(fmaxf(v[0], v[1]), fmaxf(v[2], v[3]))); }
                mx = max_x32(max_x16(mx, lane), lane);
                if (fq == 0) MX[(ai * HALF + wr * 64 + m * 16 + fr) * 4 + wc] = mx; } }
        asm volatile("s_waitcnt lgkmcnt(0)" ::: "memory"); __builtin_amdgcn_s_barrier(); asm volatile("" ::: "memory");
#pragma unroll
        for (int ai = 0; ai < 2; ++ai)
#pragma unroll
            for (int m = 0; m < 4; ++m) { const int R = ai * HALF + wr * 64 + m * 16 + fr; const f32x4 mv = *(const LAS f32x4*)(MX + R * 4);
                const float gm = fmaxf(fmaxf(mv[0], mv[1]), fmaxf(mv[2], mv[3])); float s = 0.f;
#pragma unroll
                for (int bj = 0; bj < 2; ++bj)
#pragma unroll
                    for (int n = 0; n < 2; ++n) { f32x4 v = acc[ai][bj][m][n];
#pragma unroll
                        for (int q = 0; q < 4; ++q) { v[q] = __builtin_amdgcn_exp2f(v[q] - gm); s += v[q]; }
                        acc[ai][bj][m][n] = v; }
                s = sum_x32(sum_x16(s, lane), lane);
                if (fq == 0) SM[R * 4 + wc] = s; }
        asm volatile("s_waitcnt lgkmcnt(0)" ::: "memory"); __builtin_amdgcn_s_barrier(); asm volatile("" ::: "memory");
#pragma unroll
        for (int ai = 0; ai < 2; ++ai)
#pragma unroll
            for (int m = 0; m < 4; ++m) { const int R = ai * HALF + wr * 64 + m * 16 + fr; const f32x4 sv = *(const LAS f32x4*)(SM + R * 4);
                const float inv = 1.f / ((sv[0] + sv[1]) + (sv[2] + sv[3]));
                bf16_t* rowp = P + ((size_t)u.z * SEQ + row0 + ai * HALF + m * 16) * 1024 + col0;
                if (f8) { unsigned char* rowp8 = (unsigned char*)P + ((size_t)u.z * SEQ + row0 + ai * HALF + m * 16) * 1024 + col0; const float i8 = inv * P8S;
#pragma unroll
                    for (int bj = 0; bj < 2; ++bj) { const f32x4 v0 = acc[ai][bj][m][0] * i8, v1 = acc[ai][bj][m][1] * i8;
                        u32x2 w8; w8.x = pk8(v0[0], v0[1], v0[2], v0[3]); w8.y = pk8(v1[0], v1[1], v1[2], v1[3]);
                        *(u32x2*)(rowp8 + bj * HALF) = w8; } }
                else {
#pragma unroll
                for (int bj = 0; bj < 2; ++bj) { const f32x4 v0 = acc[ai][bj][m][0] * inv, v1 = acc[ai][bj][m][1] * inv;
                    u32x4 w; w.x = cvt_pk_bf16(v0[0], v0[1]); w.y = cvt_pk_bf16(v0[2], v0[3]); w.z = cvt_pk_bf16(v1[0], v1[1]); w.w = cvt_pk_bf16(v1[2], v1[3]);
                    *(u32x4*)(rowp + bj * HALF) = w; } } }
        asm volatile("s_waitcnt lgkmcnt(0)" ::: "memory"); __builtin_amdgcn_s_barrier(); asm volatile("" ::: "memory");
    }
};
template <int NTN, bool UP> struct MoeOrder {
    int cv;
    const int* ltok; const char* A; const char* B; size_t bstride; int lda, ldb, G, c;
    __device__ __forceinline__ const int* idx(const Unit& u) const { return ltok + (size_t)u.z * T; }
    __device__ __forceinline__ bool next(int i, Unit& u) const {
        const long L = (long)i * G + c; long accu = 0; int base = 0;
        for (int e = 0; e < NE; ++e) { const int n = __builtin_amdgcn_readlane(cv, e); const int nt = ((n + 255) >> 8) * NTN;
            if (L < accu + nt) { const int r = (int)(L - accu); u.pm = r / NTN; u.pn = r % NTN; u.z = e; u.n = n; u.base = base;
                u.A = UP ? A : A + (size_t)(base + u.pm * BM) * lda * 2; u.B = B + (size_t)e * bstride + (size_t)u.pn * BM * ldb * 2; return true; }
            accu += nt; base += (n + 255) & ~255; }
        return false;
    }
};
template <bool F8 = false> struct EpiMoeUpF {
    static constexpr bool AFTER_DRAIN = false; static constexpr bool HAS_INIT = false; static constexpr bool HAS_PREFI = false;
    bf16_t* hid; const float* lw; const float* lr;
    __device__ __forceinline__ void operator()(const f32x4 (&acc)[2][2][4][2], const Unit& u, int wr, int wc, int fr, int fq) const {
        const int r0 = u.pm * BM + wr * 64 + fr, f0 = u.pn * 128 + wc * 32 + 8 * fq;
        float rsv[2][4], wv[2][4];
#pragma unroll
        for (int ai = 0; ai < 2; ++ai)
#pragma unroll
            for (int m = 0; m < 4; ++m) { const int r = r0 + ai * HALF + m * 16; rsv[ai][m] = lr[(size_t)u.z * T + r]; wv[ai][m] = lw[(size_t)u.z * T + r]; }
#pragma unroll
        for (int ai = 0; ai < 2; ++ai)
#pragma unroll
            for (int m = 0; m < 4; ++m) { const int r = r0 + ai * HALF + m * 16;
                if (r < u.n) { const float rs = rsv[ai][m] * (F8 ? 1.f / W8S : 1.f), w = wv[ai][m] * (F8 ? H8S : 1.f); float hv[8];
#pragma unroll
                    for (int q = 0; q < 8; ++q) { const float a = acc[ai][0][m][q >> 2][q & 3] * rs, b = acc[ai][1][m][q >> 2][q & 3] * rs;
                        hv[q] = a * __builtin_amdgcn_rcpf(1.f + __builtin_amdgcn_exp2f(-a * LOG2E)) * b * w; }
                    if constexpr (F8) { u32x2 o8; o8.x = pk8(clamp8(hv[0]), clamp8(hv[1]), clamp8(hv[2]), clamp8(hv[3])); o8.y = pk8(clamp8(hv[4]), clamp8(hv[5]), clamp8(hv[6]), clamp8(hv[7]));
                        *(u32x2*)((unsigned char*)hid + (size_t)(u.base + r) * DE + f0) = o8; }
                    else { u32x4 o; o.x = cvt_pk_bf16(hv[0], hv[1]); o.y = cvt_pk_bf16(hv[2], hv[3]); o.z = cvt_pk_bf16(hv[4], hv[5]); o.w = cvt_pk_bf16(hv[6], hv[7]);
                        *(u32x4*)(hid + (size_t)(u.base + r) * DE + f0) = o; } } }
    }
};
template <bool F8 = false> struct EpiMoeDownF {
    static constexpr bool AFTER_DRAIN = false; static constexpr bool HAS_INIT = false; static constexpr bool HAS_PREFI = true;
    bf16_t* Y; const int* ltok;
    __device__ __forceinline__ void pref_load_i(int (&ev)[2][4], const Unit& u, int wr, int fr) const {
        const int r0 = u.pm * BM + wr * 64 + fr;
#pragma unroll
        for (int ai = 0; ai < 2; ++ai)
#pragma unroll
            for (int m = 0; m < 4; ++m) ev[ai][m] = ltok[(size_t)u.z * T + r0 + ai * HALF + m * 16];
    }
    __device__ __forceinline__ void run_pref_i(const f32x4 (&acc)[2][2][4][2], const Unit& u, int wr, int wc, int fr, int fq, int (&evp)[2][4], bool has_next, const Unit& nxt) const {
        int evn[2][4] = {{0, 0, 0, 0}, {0, 0, 0, 0}};
        if (has_next) pref_load_i(evn, nxt, wr, fr);
        body(acc, u, wr, wc, fr, fq, evp);
#pragma unroll
        for (int ai = 0; ai < 2; ++ai)
#pragma unroll
            for (int m = 0; m < 4; ++m) evp[ai][m] = evn[ai][m];
    }
    __device__ __forceinline__ void operator()(const f32x4 (&acc)[2][2][4][2], const Unit& u, int wr, int wc, int fr, int fq) const {
        int ev[2][4]; pref_load_i(ev, u, wr, fr); body(acc, u, wr, wc, fr, fq, ev);
    }
    __device__ __forceinline__ void body(const f32x4 (&acc)[2][2][4][2], const Unit& u, int wr, int wc, int fr, int fq, const int (&ev)[2][4]) const {
        const int r0 = u.pm * BM + wr * 64 + fr, col0 = u.pn * BM + wc * 32 + 8 * fq;
#pragma unroll
        for (int ai = 0; ai < 2; ++ai)
#pragma unroll
            for (int m = 0; m < 4; ++m) { const int r = r0 + ai * HALF + m * 16;
                if (r < u.n) { const int e = ev[ai][m]; bf16_t* rowp = Y + ((size_t)(e & 1) * T + (e >> 1)) * D + col0;
#pragma unroll
                    for (int bj = 0; bj < 2; ++bj) { constexpr float ds = F8 ? Y8S / (W8S * H8S) : 1.f; const f32x4 v0 = acc[ai][bj][m][0] * ds, v1 = acc[ai][bj][m][1] * ds;
                        if constexpr (F8) { u32x2 w8; w8.x = pk8(clamp8(v0[0]), clamp8(v0[1]), clamp8(v0[2]), clamp8(v0[3])); w8.y = pk8(clamp8(v1[0]), clamp8(v1[1]), clamp8(v1[2]), clamp8(v1[3]));
                            *(u32x2*)((unsigned char*)Y + ((size_t)(e & 1) * T + (e >> 1)) * D + col0 + bj * HALF) = w8; }
                        else { u32x4 w; w.x = cvt_pk_bf16(v0[0], v0[1]); w.y = cvt_pk_bf16(v0[2], v0[3]); w.z = cvt_pk_bf16(v1[0], v1[1]); w.w = cvt_pk_bf16(v1[2], v1[3]);
                            *(u32x4*)(rowp + bj * HALF) = w; } } } }
    }
};
}

constexpr int NPRO = 3, NPL = 9, NPH = NPRO + NL * NPL;
#ifndef Q_X1
#define Q_X1 8
#endif
#ifndef Q_UP
#define Q_UP 8
#endif

__global__ void __launch_bounds__(NTHREADS, 2) mk_fwd(Args args) {
    extern __shared__ __attribute__((aligned(16))) unsigned char lds_raw[];
    Ctx C;
    C.ka = (const __attribute__((address_space(4))) unsigned char*)__builtin_amdgcn_kernarg_segment_ptr();
    C.out = args.out; C.ws = (GAS unsigned char*)args.ws;
    C.lds = (LAS unsigned char*)lds_raw;
    C.tid = threadIdx.x; C.lane = C.tid & 63; C.wave = __builtin_amdgcn_readfirstlane(C.tid >> 6);
    C.gw = blockIdx.x * NWAVES + C.wave; C.ngw = gridDim.x * NWAVES;
    volatile LAS unsigned* MISC = (volatile LAS unsigned*)(C.lds + LDS_MISC);
    if (C.tid < 32) MISC[C.tid] = 0u;
    __syncthreads();
    XcdBarrier bar = xcd_barrier_post(WSP(unsigned, WS_CTL) + CW_BAR, MISC + 8);
    const int lo = args.ph_lo, hi = args.ph_hi;
    const int G = (int)gridDim.x, cb = (int)blockIdx.x;
#define XCD_C(tot) ((G >= (tot)) ? ((cb < (tot)) ? ((cb & 7) * ((tot) >> 3) + (cb >> 3)) : (tot)) : cb)
#define XCD_G(tot) ((G >= (tot)) ? (1 << 20) : G)
    int p = 0;
#define PH_BEGIN if (p >= lo && p < hi) { { unsigned z0_ = 0u; asm volatile("" : "+s"(C.ws), "+s"(z0_), "+s"(C.ka));     \
        C.lane = (int)__builtin_amdgcn_mbcnt_hi(~0u, __builtin_amdgcn_mbcnt_lo(~0u, z0_)); C.tid = C.wave * 64 + C.lane; }
#define PH_END   if (p + 1 < hi) xcd_barrier(bar, C.tid); else __syncthreads(); } ++p;

    PH_BEGIN phase_prologue(C); PH_END
    PH_BEGIN
        pg8::MultiOrder S{(const char*)WSP(unsigned char, WS_MEMB), (const char*)WSP(unsigned char, WS_WKV), 0, 0, 0, (size_t)4096 * D, 0, 0, 0, 0, 0, 2, 16, NL, D / 2, D / 2, XCD_G(128), XCD_C(128)};
        pg8::EpiStore<2, false, true> E{WSP(bf16_t, WS_KVB), (size_t)MT * 4096, 0, 0, 0, 4096, WSP(float, WS_RMEM), 0, 1.f / W8S};
        pg8::gemm_phase<pg8::EpiStore<2, false, true>, pg8::MultiOrder, true, false, true>(C.lds, C.tid, D / 2, D / 2, D / 2, S, E);
    PH_END
    PH_BEGIN
        { pg8::MultiOrder S{(const char*)WSP(unsigned char, WS_KVB), (const char*)WSP(unsigned char, WS_WQS), (size_t)MEM * 4096, 512, 0, 0, 512, (size_t)D * D, 2, 3, 3, 1, 8, NL * NB * 4, 2048, D / 2, XCD_G(256), XCD_C(256)};
          pg8::EpiStore<0, false, true> E{WSP(bf16_t, WS_WQK), (size_t)1024 * D, (size_t)256 * D, 2, 3, D, nullptr, 0, V8S / Q8S};
          pg8::gemm_phase<pg8::EpiStore<0, false, true>, pg8::MultiOrder, false, false, true>(C.lds, C.tid, 2048, D / 2, 256, S, E); }
        { pg8::MultiOrder S{(const char*)WSP(unsigned char, WS_WXO), (const char*)(WSP(unsigned char, WS_KVB) + 2048), 0, 512, (size_t)D * D, (size_t)MEM * 4096, 512, 0, 2, 3, 3, 8, 1, NL * NB * 4, D / 2, 2048, XCD_G(256), XCD_C(256)};
          pg8::EpiStore<0, false, true> E{WSP(bf16_t, WS_VOT), (size_t)D * 1024, 256, 2, 3, 1024, nullptr, 0, V8S / W8S};
          pg8::gemm_phase<pg8::EpiStore<0, false, true>, pg8::MultiOrder, false, false, true>(C.lds, C.tid, D / 2, 2048, 256, S, E); }
    PH_END
    for (int l = 0; l < NL; ++l) {
        PH_BEGIN { { pg8::MaskOrder S; S.init(WSP(bf16_t, WS_XB), WSP(bf16_t, WS_WIN) + (size_t)l * INW * D, D, D, T, l >= L8 ? 0u : 0xFFFFFFu, G, cb);
                     pg8::EpiStore<1> E{WSP(bf16_t, WS_PROJ), 0, 0, 0, 0, INW, WSP(float, WS_PART), 0, 1.f};
                     pg8::gemm_phase<pg8::EpiStore<1>, pg8::MaskOrder, true>(C.lds, C.tid, D, D, D, S, E); }
                   { pg8::MaskOrder S; S.init(WSP(unsigned char, WS_X8), WSP(bf16_t, WS_WIN) + (size_t)l * INW * D, D / 2, D / 2, T, l >= L8 ? 0xFFFFFFu : 0u, G, cb);
                     pg8::EpiStore<1, true> E{WSP(bf16_t, WS_PROJ), 0, 0, 0, 0, INW, WSP(float, WS_PART), 0, 1.f};
                     pg8::gemm_phase<pg8::EpiStore<1, true>, pg8::MaskOrder, true, false, true>(C.lds, C.tid, D / 2, D / 2, D / 2, S, E); } } PH_END
        PH_BEGIN phase_attn(C, l); PH_END
        PH_BEGIN { pg8::DenseOrder S; pg8::EpiResidualPart E{WSP(bf16_t, WS_XB), WSP(float, WS_PART), 0, l >= L8X ? WSP(unsigned char, WS_X8) : nullptr, l >= L8B ? 1.f / W8S : 1.f};
                   if (l >= L8B) { S.init(WSP(bf16_t, WS_MIX), WSP(bf16_t, WS_WOUT) + (size_t)l * D * D, D / 2, D / 2, T, D, G, cb);
                       pg8::gemm_phase<pg8::EpiResidualPart, pg8::DenseOrder, false, false, true>(C.lds, C.tid, D / 2, D / 2, D / 2, S, E); }
                   else { S.init(WSP(bf16_t, WS_MIX), WSP(bf16_t, WS_WOUT) + (size_t)l * D * D, D, D, T, D, G, cb);
                       pg8::gemm_phase<pg8::EpiResidualPart, pg8::DenseOrder, false>(C.lds, C.tid, D, D, D, S, E); } } PH_END
        PH_BEGIN { if (l + 1 < NL && G >= 256 && cb >= 128) convert_pull(C, l + 1, Q_X1, nullptr);
                   pg8::MultiOrder S{(const char*)WSP(bf16_t, WS_XB), (const char*)(WSP(bf16_t, WS_WQK) + (size_t)l * NB * 1024 * D), (size_t)SEQ * D * 2, 0, 0, (size_t)1024 * D * 2, 0, 0, 0, 0, 0, 16, 4, NB, D, D, XCD_G(128), XCD_C(128)};
                   pg8::EpiSoftmaxP E{WSP(bf16_t, WS_P), WSP(float, WS_PART), l >= L8X ? 1 : 0, l >= L8X ? 1.f / V8S : 1.f};
                   if (l >= L8X) { S.A = (const char*)WSP(unsigned char, WS_X8); S.a1 = (size_t)SEQ * D; S.lda = D / 2; S.ldb = D / 2; S.B = (const char*)WSP(unsigned char, WS_WQK) + (size_t)l * NB * 1024 * D; S.b1 = (size_t)1024 * D;
                       pg8::gemm_phase<pg8::EpiSoftmaxP, pg8::MultiOrder, false, false, true>(C.lds, C.tid, D / 2, D / 2, D / 2, S, E); }
                   else pg8::gemm_phase<pg8::EpiSoftmaxP, pg8::MultiOrder, false>(C.lds, C.tid, D, D, D, S, E); } PH_END
        PH_BEGIN { pg8::MultiOrder S{(const char*)WSP(bf16_t, WS_P), (const char*)(WSP(bf16_t, WS_VOT) + (size_t)l * NB * D * 1024), (size_t)SEQ * 1024 * 2, 0, 0, (size_t)D * 1024 * 2, 0, 0, 0, 0, 0, 16, 8, NB, 1024, 1024, XCD_G(256), XCD_C(256)};
                   pg8::EpiResidualPart E{WSP(bf16_t, WS_XB), WSP(float, WS_PART), (size_t)SEQ, l >= L8M ? WSP(unsigned char, WS_X8) : nullptr, l >= L8X ? 1.f / (P8S * V8S) : 1.f};
                   if (l >= L8X) { S.a1 = (size_t)SEQ * 1024; S.lda = 512; S.ldb = 512; S.B = (const char*)WSP(unsigned char, WS_VOT) + (size_t)l * NB * D * 1024; S.b1 = (size_t)D * 1024;
                       pg8::gemm_phase<pg8::EpiResidualPart, pg8::MultiOrder, false, false, true>(C.lds, C.tid, 512, 512, 512, S, E); }
                   else pg8::gemm_phase<pg8::EpiResidualPart, pg8::MultiOrder, false>(C.lds, C.tid, 1024, 1024, 1024, S, E); } PH_END
        PH_BEGIN phase_router(C, l); PH_END
        PH_BEGIN { pg8::MoeOrder<2, true> S{(int)(WSP(unsigned, WS_CTL) + CW_CNT + l * NE * CNT_STRIDE)[(C.lane & 31) * CNT_STRIDE], WSP(int, WS_LTOK), (const char*)WSP(bf16_t, WS_XB), (const char*)(WSP(bf16_t, WS_W13) + (size_t)l * NE * 512 * D), (size_t)512 * D * 2, D, D, G, cb};
                   { pg8::Unit u0; if (l + 1 < NL && !S.next(0, u0)) convert_pull(C, l + 1, Q_UP, nullptr); }
                   if (l >= L8M) { S.A = (const char*)WSP(unsigned char, WS_X8); S.bstride = (size_t)512 * D; S.lda = D / 2; S.ldb = D / 2;
                       pg8::EpiMoeUpF<true> E{WSP(bf16_t, WS_HID), WSP(float, WS_LW), WSP(float, WS_LR)};
                       pg8::gemm_phase<pg8::EpiMoeUpF<true>, pg8::MoeOrder<2, true>, true, true, true>(C.lds, C.tid, D / 2, D / 2, D / 2, S, E); }
                   else { pg8::EpiMoeUpF<> E{WSP(bf16_t, WS_HID), WSP(float, WS_LW), WSP(float, WS_LR)};
                       pg8::gemm_phase<pg8::EpiMoeUpF<>, pg8::MoeOrder<2, true>, true, true>(C.lds, C.tid, D, D, D, S, E); } } PH_END
        PH_BEGIN { pg8::MoeOrder<8, false> S{(int)(WSP(unsigned, WS_CTL) + CW_CNT + l * NE * CNT_STRIDE)[(C.lane & 31) * CNT_STRIDE], WSP(int, WS_LTOK), (const char*)WSP(bf16_t, WS_HID), (const char*)(WSP(bf16_t, WS_W2) + (size_t)l * NE * D * DE), (size_t)D * DE * 2, DE, DE, G, cb};
                   if (l >= L8M) { S.bstride = (size_t)D * DE; S.lda = DE / 2; S.ldb = DE / 2;
                       pg8::EpiMoeDownF<true> E{WSP(bf16_t, WS_Y), WSP(int, WS_LTOK)};
                       pg8::gemm_phase<pg8::EpiMoeDownF<true>, pg8::MoeOrder<8, false>, true, false, true>(C.lds, C.tid, DE / 2, DE / 2, DE / 2, S, E); }
                   else { pg8::EpiMoeDownF<> E{WSP(bf16_t, WS_Y), WSP(int, WS_LTOK)};
                       pg8::gemm_phase<pg8::EpiMoeDownF<>, pg8::MoeOrder<8, false>, true, false>(C.lds, C.tid, DE, DE, DE, S, E); } } PH_END
        PH_BEGIN phase_combine(C, l); if (l + 1 < NL) convert_pull(C, l + 1, LAYER_ITEMS, nullptr); PH_END
    }
}

extern "C" void kernel_launch(void* const* d_in, const int* in_sizes, int n_in, void* d_out, int out_size, void* d_ws, size_t ws_size, hipStream_t stream) {
    static int grid = 0;
    if (grid == 0) {
        if (n_in != 23 || in_sizes[0] != T * D || out_size != T * D || ws_size < WS_END) {
            fprintf(stderr, "kernel_launch: unexpected problem (n_in %d, in0 %d, out %d, ws %zu < %zu); nothing launched\n", n_in, n_in > 0 ? in_sizes[0] : -1, out_size, ws_size, (size_t)WS_END);
            grid = -1; return; }
        int dev = 0, cus = 0, per_cu = 0;
        if (hipGetDevice(&dev) != hipSuccess || hipDeviceGetAttribute(&cus, hipDeviceAttributeMultiprocessorCount, dev) != hipSuccess) { grid = -1; return; }
        if (hipFuncSetAttribute((const void*)mk_fwd, hipFuncAttributeMaxDynamicSharedMemorySize, LDS_BYTES) != hipSuccess) { fprintf(stderr, "kernel_launch: hipFuncSetAttribute failed\n"); grid = -1; return; }
        if (hipOccupancyMaxActiveBlocksPerMultiprocessor(&per_cu, (const void*)mk_fwd, NTHREADS, LDS_BYTES) != hipSuccess || per_cu < 1) {
            fprintf(stderr, "kernel_launch: occupancy query reports %d workgroups per CU\n", per_cu); (void)hipGetLastError(); grid = -1; return; }
        grid = cus;
    }
    if (grid < 0) return;
    if (hipMemsetAsync((char*)d_ws + WS_CTL, 0, CTL_BYTES, stream) != hipSuccess) return;
    Args a{};
    for (int i = 0; i < 23; ++i) a.in[i] = (const float*)d_in[i];
    a.out = (float*)d_out; a.ws = (unsigned char*)d_ws;
#if MK_MULTI
    for (int p = 0; p < NPH; ++p) { a.ph_lo = p; a.ph_hi = p + 1; hipLaunchKernelGGL(mk_fwd, dim3(grid), dim3(NTHREADS), LDS_BYTES, stream, a); }
#else
    a.ph_lo = 0; a.ph_hi = NPH;
    hipLaunchKernelGGL(mk_fwd, dim3(grid), dim3(NTHREADS), LDS_BYTES, stream, a);
#endif
    const hipError_t le = hipPeekAtLastError();
    if (le != hipSuccess) fprintf(stderr, "kernel_launch: launch failed: %s\n", hipGetErrorName(le));
}
```
